# Optimizing an MI355X kernel written in HIP

```python
import jax, jax.numpy as jnp
from jax import lax
import numpy as np

D_MODEL = 2048
BATCH = 4
SEQ = 2048
DEPTH = 2

GRID_W = 64
CTX_LEN = 256
N_BRANCH = 4
BRANCH_W = D_MODEL // N_BRANCH
HEAD_DIM = 64
N_HEADS = BRANCH_W // HEAD_DIM
N_KV_HEADS = 2
WINDOW = 128
BLOCK = 128
ROPE_THETA = 10000.0
SGU_CHUNK = 128
SGU_GROUPS = 4
SGU_GROUP_W = BRANCH_W // SGU_GROUPS
SCONV_K = 3
CONF_K = 31
N_EXPERTS = 16
N_GROUPS = 4
EXPERTS_PER_GROUP = N_EXPERTS // N_GROUPS
TOP_K = 2
D_FF_EXPERT = D_MODEL // 2
Q_W = N_HEADS * HEAD_DIM
KV_W = N_KV_HEADS * HEAD_DIM
SECTION_WIDTHS = (Q_W, KV_W, KV_W, BRANCH_W, BRANCH_W, BRANCH_W, BRANCH_W, BRANCH_W, BRANCH_W, BRANCH_W, N_BRANCH * D_MODEL)
N_IN = Q_W + 2 * KV_W + 7 * BRANCH_W + N_BRANCH * D_MODEL

kernel_name = "hybrid_parallel_gated_mixers_grouped_moe_dit"

F32 = jnp.float32


def rmsnorm(x, g, eps=1e-6):
    xf = x.astype(F32)
    y = xf * lax.rsqrt(jnp.mean(xf * xf, axis=-1, keepdims=True) + eps)
    return (y * g.astype(F32)).astype(x.dtype)


def layernorm(x, g, b, eps=1e-5):
    xf = x.astype(F32)
    mu = jnp.mean(xf, axis=-1, keepdims=True)
    var = jnp.mean(jnp.square(xf - mu), axis=-1, keepdims=True)
    y = (xf - mu) * lax.rsqrt(var + eps) * g.astype(F32) + b.astype(F32)
    return y.astype(x.dtype)


def split_sections(p):
    pts, acc = [], 0
    for w in SECTION_WIDTHS[:-1]:
        acc += w
        pts.append(acc)
    return jnp.split(p, pts, axis=-1)


def axial_rope_tables(n):
    rows = n // GRID_W
    row = jnp.broadcast_to(jnp.arange(rows)[:, None], (rows, GRID_W)).reshape(-1)
    col = jnp.broadcast_to(jnp.arange(GRID_W)[None, :], (rows, GRID_W)).reshape(-1)
    half = HEAD_DIM // 2
    inv = 1.0 / (ROPE_THETA ** (jnp.arange(0, half, 2, dtype=F32) / half))
    ang_r = row.astype(F32)[:, None, None] * inv
    ang_c = col.astype(F32)[:, None, None] * inv
    return jnp.cos(ang_r), jnp.sin(ang_r), jnp.cos(ang_c), jnp.sin(ang_c)


def rotate(x, cos, sin):
    xf = x.astype(F32)
    x1, x2 = jnp.split(xf, 2, axis=-1)
    return jnp.concatenate([x1 * cos - x2 * sin, x2 * cos + x1 * sin], axis=-1).astype(x.dtype)


def axial_rope(x, tabs):
    cr, sr, cc, sc = tabs
    half = HEAD_DIM // 2
    return jnp.concatenate([rotate(x[..., :half], cr, sr), rotate(x[..., half:], cc, sc)], axis=-1)


def window_attention(q, k, v, kc, vc, sink):
    b, s, h, dh = q.shape
    g = k.shape[2]
    r = h // g
    nb = s // BLOCK
    scale = dh ** -0.5
    qb = q.reshape(b, nb, BLOCK, g, r, dh)

    def band(t):
        tp = jnp.pad(t, ((0, 0), (BLOCK, BLOCK), (0, 0), (0, 0))).reshape(b, nb + 2, BLOCK, g, dh)
        return jnp.concatenate([tp[:, :-2], tp[:, 1:-1], tp[:, 2:]], axis=2)

    kb, vb = band(k), band(v)
    s_loc = jnp.einsum('bnqgrd,bnkgd->bngrqk', qb, kb).astype(F32) * scale
    qpos = jnp.arange(nb)[:, None] * BLOCK + jnp.arange(BLOCK)[None, :]
    kpos = jnp.arange(nb)[:, None] * BLOCK - BLOCK + jnp.arange(3 * BLOCK)[None, :]
    valid = (jnp.abs(qpos[:, :, None] - kpos[:, None, :]) <= WINDOW) & (kpos[:, None, :] >= 0) & (kpos[:, None, :] < s)
    s_loc = jnp.where(valid[None, :, None, None], s_loc, -jnp.inf)
    s_ctx = jnp.einsum('bnqgrd,bmgd->bngrqm', qb, kc).astype(F32) * scale
    sink_b = jnp.broadcast_to(sink.astype(F32).reshape(g, r)[None, None, :, :, None, None], s_loc.shape[:-1] + (1,))
    p = jax.nn.softmax(jnp.concatenate([s_loc, s_ctx, sink_b], axis=-1), axis=-1)
    nk = 3 * BLOCK
    lc = kc.shape[1]
    p_loc = p[..., :nk].astype(v.dtype)
    p_ctx = p[..., nk:nk + lc].astype(v.dtype)
    o = jnp.einsum('bngrqk,bnkgd->bnqgrd', p_loc, vb) + jnp.einsum('bngrqm,bmgd->bnqgrd', p_ctx, vc)
    return o.reshape(b, s, h * dh)


def context_attention(qc, kc, vc, sink):
    b, l, h, dh = qc.shape
    g = kc.shape[2]
    r = h // g
    qg = qc.reshape(b, l, g, r, dh)
    s = jnp.einsum('blgrd,bmgd->bgrlm', qg, kc).astype(F32) * (dh ** -0.5)
    sink_b = jnp.broadcast_to(sink.astype(F32).reshape(g, r)[None, :, :, None, None], s.shape[:-1] + (1,))
    p = jax.nn.softmax(jnp.concatenate([s, sink_b], axis=-1), axis=-1)
    o = jnp.einsum('bgrlm,bmgd->blgrd', p[..., :l].astype(vc.dtype), vc)
    return o.reshape(b, l, h * dh)


def chunk_sgu(u, v, ln_g, ln_b, w_s, b_s):
    b, t, w = u.shape
    u = jax.nn.gelu(u)
    v = layernorm(jax.nn.gelu(v), ln_g, ln_b)
    vr = v.reshape(b, t // SGU_CHUNK, SGU_CHUNK, SGU_GROUPS, SGU_GROUP_W)
    sp = jnp.einsum('gpq,bnqgc->bnpgc', w_s, vr) + b_s.T[:, :, None]
    return u * sp.reshape(b, t, w)


def dwconv(x, w):
    kw = w.shape[0]
    return lax.conv_general_dilated(x, w[:, None, :].astype(x.dtype), window_strides=(1,),
                                    padding=((kw // 2, kw // 2),),
                                    dimension_numbers=('NWC', 'WIO', 'NWC'),
                                    feature_group_count=x.shape[-1])


def conformer_conv(a, bgate, dw_w, dw_b, ln_g, ln_b):
    z = a * jax.nn.sigmoid(bgate)
    z = dwconv(z, dw_w) + dw_b
    z = layernorm(z, ln_g, ln_b)
    return jax.nn.silu(z)


def branch_mix(attn_y, su, sv, cb, cc, cx, ga, gb, gates,
               sgu_ln_g, sgu_ln_b, sgu_w, sgu_b, sconv_w,
               conf_dw_w, conf_dw_b, conf_ln_g, conf_ln_b, w_branch, w_out):
    y_b = chunk_sgu(su, sv, sgu_ln_g, sgu_ln_b, sgu_w, sgu_b)
    y_c = cb * dwconv(cc * cx, sconv_w)
    y_d = conformer_conv(ga, gb, conf_dw_w, conf_dw_b, conf_ln_g, conf_ln_b)
    gates = jax.nn.sigmoid(gates.astype(F32)).astype(attn_y.dtype)
    merged = 0.0
    for i, y in enumerate((attn_y, y_b, y_c, y_d)):
        merged = merged + gates[..., i * D_MODEL:(i + 1) * D_MODEL] * (y @ w_branch[i])
    return merged @ w_out


def moe(h, router_w, router_b, w_up, w_down):
    t = h.shape[0]
    scores = jax.nn.softmax((h @ router_w).astype(F32), axis=-1)
    biased = scores + router_b.astype(F32)
    grp_score = lax.top_k(biased.reshape(t, N_GROUPS, EXPERTS_PER_GROUP), TOP_K)[0].sum(-1)
    gsel = jnp.argmax(grp_score, axis=-1)
    in_group = (jnp.arange(N_EXPERTS) // EXPERTS_PER_GROUP)[None, :] == gsel[:, None]
    _, idx = lax.top_k(jnp.where(in_group, biased, -jnp.inf), TOP_K)
    wsel = jnp.take_along_axis(scores, idx, axis=-1)
    wsel = wsel / jnp.sum(wsel, axis=-1, keepdims=True)
    comb = jnp.sum(jax.nn.one_hot(idx, N_EXPERTS, dtype=F32) * wsel[..., None], axis=1).astype(h.dtype)
    y = jnp.zeros_like(h)
    for e in range(N_EXPERTS):
        a, b = jnp.split(h @ w_up[e], 2, axis=-1)
        y = y + comb[:, e:e + 1] * ((jax.nn.silu(a) * b) @ w_down[e])
    return y


def setup_inputs(seed: int = 0) -> dict:
    key = jax.random.key(seed)
    ks = jax.random.split(key, 32)

    def nrm(k, shape, scale):
        return jax.random.normal(k, shape, jnp.float32) * scale

    D = D_MODEL
    return {
        "x": nrm(ks[0], (BATCH, SEQ, D), 1.0),
        "c": nrm(ks[1], (BATCH, D), 1.0),
        "ctx": nrm(ks[2], (BATCH, CTX_LEN, D), 1.0),
        "c_ctx": nrm(ks[3], (D,), 1.0),
        "ada_w": nrm(ks[4], (DEPTH, D, 6 * D), 0.3 * D ** -0.5),
        "ada_b": nrm(ks[5], (DEPTH, 6 * D), 0.01),
        "norm1_g": 1.0 + nrm(ks[6], (DEPTH, D), 0.02),
        "norm2_g": 1.0 + nrm(ks[7], (DEPTH, D), 0.02),
        "w_in": nrm(ks[8], (DEPTH, D, N_IN), D ** -0.5),
        "attn_sink": nrm(ks[9], (DEPTH, N_HEADS), 0.5),
        "sgu_ln_g": 1.0 + nrm(ks[10], (DEPTH, BRANCH_W), 0.02),
        "sgu_ln_b": nrm(ks[11], (DEPTH, BRANCH_W), 0.02),
        "sgu_w": nrm(ks[12], (DEPTH, SGU_GROUPS, SGU_CHUNK, SGU_CHUNK), SGU_CHUNK ** -0.5),
        "sgu_b": 1.0 + nrm(ks[13], (DEPTH, SGU_GROUPS, SGU_CHUNK), 0.02),
        "sconv_w": nrm(ks[14], (DEPTH, SCONV_K, BRANCH_W), SCONV_K ** -0.5),
        "conf_dw_w": nrm(ks[15], (DEPTH, CONF_K, BRANCH_W), CONF_K ** -0.5),
        "conf_dw_b": nrm(ks[16], (DEPTH, BRANCH_W), 0.02),
        "conf_ln_g": 1.0 + nrm(ks[17], (DEPTH, BRANCH_W), 0.02),
        "conf_ln_b": nrm(ks[18], (DEPTH, BRANCH_W), 0.02),
        "w_branch": nrm(ks[19], (DEPTH, N_BRANCH, BRANCH_W, D), BRANCH_W ** -0.5),
        "w_out": nrm(ks[20], (DEPTH, D, D), D ** -0.5),
        "router_w": nrm(ks[21], (D, N_EXPERTS), D ** -0.5),
        "router_b": nrm(ks[22], (N_EXPERTS,), 0.01),
        "exp_w_up": nrm(ks[23], (DEPTH, N_EXPERTS, D, 2 * D_FF_EXPERT), D ** -0.5),
        "exp_w_down": nrm(ks[24], (DEPTH, N_EXPERTS, D_FF_EXPERT, D), D_FF_EXPERT ** -0.5),
        "final_g": 1.0 + nrm(ks[25], (D,), 0.02),
    }


def reference(x, c, ctx, c_ctx, ada_w, ada_b, norm1_g, norm2_g, w_in, attn_sink,
              sgu_ln_g, sgu_ln_b, sgu_w, sgu_b, sconv_w, conf_dw_w, conf_dw_b,
              conf_ln_g, conf_ln_b, w_branch, w_out, router_w, router_b,
              exp_w_up, exp_w_down, final_g):
    b, s, d = x.shape
    l_ctx = ctx.shape[1]
    tabs = axial_rope_tables(s)
    cx = ctx
    silu_c = jax.nn.silu(c)
    silu_cc = jax.nn.silu(c_ctx)[None, :]
    for l in range(DEPTH):
        last = l == DEPTH - 1
        sh1, sc1, g1, sh2, sc2, g2 = jnp.split((silu_c @ ada_w[l] + ada_b[l])[:, None, :], 6, axis=-1)
        sh1c, sc1c, g1c, sh2c, sc2c, g2c = jnp.split((silu_cc @ ada_w[l] + ada_b[l])[:, None, :], 6, axis=-1)
        lp = (sgu_ln_g[l], sgu_ln_b[l], sgu_w[l], sgu_b[l], sconv_w[l],
              conf_dw_w[l], conf_dw_b[l], conf_ln_g[l], conf_ln_b[l], w_branch[l], w_out[l])

        hx = rmsnorm(x, norm1_g[l]) * (1 + sc1) + sh1
        hc = rmsnorm(cx, norm1_g[l]) * (1 + sc1c) + sh1c
        px = split_sections(hx @ w_in[l])
        pc = split_sections(hc @ w_in[l])
        kc = pc[1].reshape(b, l_ctx, N_KV_HEADS, HEAD_DIM)
        vc = pc[2].reshape(b, l_ctx, N_KV_HEADS, HEAD_DIM)
        q = axial_rope(px[0].reshape(b, s, N_HEADS, HEAD_DIM), tabs)
        k = axial_rope(px[1].reshape(b, s, N_KV_HEADS, HEAD_DIM), tabs)
        v = px[2].reshape(b, s, N_KV_HEADS, HEAD_DIM)
        ya = window_attention(q, k, v, kc, vc, attn_sink[l])
        x_new = x + g1 * branch_mix(ya, *px[3:], *lp)
        if not last:
            yac = context_attention(pc[0].reshape(b, l_ctx, N_HEADS, HEAD_DIM), kc, vc, attn_sink[l])
            cx = cx + g1c * branch_mix(yac, *pc[3:], *lp)
        x = x_new

        hx2 = (rmsnorm(x, norm2_g[l]) * (1 + sc2) + sh2).reshape(b * s, d)
        if not last:
            hc2 = (rmsnorm(cx, norm2_g[l]) * (1 + sc2c) + sh2c).reshape(b * l_ctx, d)
            tokens = jnp.concatenate([hx2, hc2], axis=0)
        else:
            tokens = hx2
        yt = moe(tokens, router_w, router_b, exp_w_up[l], exp_w_down[l])
        x = x + g2 * yt[:b * s].reshape(b, s, d)
        if not last:
            cx = cx + g2c * yt[b * s:].reshape(b, l_ctx, d)
    return rmsnorm(x, final_g)
```

```cpp
#include <hip/hip_runtime.h>
#include <cstdio>
#include <cstdint>

#ifndef DBG_LAST
#define DBG_LAST 18
#endif
#ifndef DBG_MIX
#define DBG_MIX 15
#endif
#ifndef MK_N_LAUNCHES
#define MK_N_LAUNCHES 0
#endif

#define LAS __attribute__((address_space(3)))
#define GAS __attribute__((address_space(1)))
typedef unsigned short bf16_t;
typedef short bf16x8 __attribute__((ext_vector_type(8)));
typedef float f32x4 __attribute__((ext_vector_type(4)));
typedef float f32x2 __attribute__((ext_vector_type(2)));
typedef float f32x16 __attribute__((ext_vector_type(16)));
typedef unsigned u32x4 __attribute__((ext_vector_type(4)));
typedef unsigned u32x2 __attribute__((ext_vector_type(2)));

constexpr int D = 2048, NBATCH = 4, SEQ = 2048, LCTX = 256;
constexpr int TL = NBATCH * SEQ;
constexpr int TC = NBATCH * LCTX;
constexpr int TT = TL + TC;
constexpr int NIN = 12544, NTIN = 49;
constexpr int BW = 512;
constexpr int NE = 16, DFF = 1024;
constexpr int NWAVES = 8, NTHR = 512;
constexpr float LOG2E = 1.4426950408889634f;
constexpr float QSCALE = 0.125f * LOG2E;

constexpr size_t al256(size_t x) { return (x + 255) & ~(size_t)255; }
constexpr size_t WS_CTL = 0, CTL_BYTES = 1u << 20;
constexpr size_t WS_MOD = WS_CTL + CTL_BYTES;
constexpr size_t WS_ROPE = WS_MOD + al256((size_t)2 * 5 * 12288 * 4);
constexpr size_t WS_WIN = WS_ROPE + al256(64 * 32 * 4);
constexpr size_t WS_WB = WS_WIN + (size_t)2 * NIN * D * 2;
constexpr size_t WS_WO = WS_WB + (size_t)2 * 4 * D * BW * 2;
constexpr size_t WS_WUP = WS_WO + (size_t)2 * D * D * 2;
constexpr size_t WS_WDN = WS_WUP + (size_t)32 * D * D * 2;
constexpr size_t WS_XS = WS_WDN + (size_t)32 * D * DFF * 2;
constexpr size_t WS_H = WS_XS + (size_t)TT * D * 4;
constexpr size_t WS_Q = WS_H + (size_t)TT * D * 2;
constexpr size_t WS_K = WS_Q + (size_t)TT * BW * 2;
constexpr size_t WS_V = WS_K + (size_t)TT * 128 * 2;
constexpr size_t WS_GU = WS_V + (size_t)TT * 128 * 2;
constexpr size_t WS_GV = WS_GU + (size_t)TT * BW * 2;
constexpr size_t WS_CB = WS_GV + (size_t)TT * BW * 2;
constexpr size_t WS_CU = WS_CB + (size_t)TT * BW * 2;
constexpr size_t WS_Z = WS_CU + (size_t)TT * BW * 2;
constexpr size_t WS_G = WS_Z + (size_t)TT * BW * 2;
constexpr size_t WS_Y = WS_G + (size_t)TT * 8192 * 2;
constexpr size_t WS_MS = WS_Y + (size_t)4 * TT * BW * 2;
constexpr size_t WS_MG = WS_MS + (size_t)256 * 65536 * 4;
constexpr size_t WS_LT = WS_MG + (size_t)TT * D * 2;
constexpr size_t WS_LW = WS_LT + (size_t)NE * TT * 4;
constexpr int ACT_ROWS = 2 * TT + NE * 256;
constexpr size_t WS_ACT = WS_LW + (size_t)NE * TT * 4;
constexpr size_t WS_YT = WS_ACT + (size_t)ACT_ROWS * DFF * 2;
constexpr size_t WS_END = WS_YT + (size_t)2 * TT * D * 2;
constexpr int CW_CNT = 64;
constexpr int CW_BAR = 4096;

constexpr int RING_BYTES = 131072;
constexpr int LDSCTL_OFF = 135168;
constexpr int MISC_OFF = LDSCTL_OFF + 320;
constexpr int LDS_BYTES = 147456;

__device__ __forceinline__ unsigned f2bf(float f) { unsigned u = __builtin_bit_cast(unsigned, f); return (u + 0x7fffu + ((u >> 16) & 1u)) >> 16; }
__device__ __forceinline__ unsigned pk2(float lo, float hi) { return f2bf(lo) | (f2bf(hi) << 16); }
__device__ __forceinline__ float bflo(unsigned w) { return __builtin_bit_cast(float, w << 16); }
__device__ __forceinline__ float bfhi(unsigned w) { return __builtin_bit_cast(float, w & 0xffff0000u); }
__device__ __forceinline__ f32x4 bf4_to_f32(u32x2 w) { return (f32x4){bflo(w.x), bfhi(w.x), bflo(w.y), bfhi(w.y)}; }
__device__ __forceinline__ u32x2 f32_to_bf4(f32x4 v) { u32x2 w; w.x = pk2(v[0], v[1]); w.y = pk2(v[2], v[3]); return w; }
__device__ __forceinline__ float wave_sum(float v) {
#pragma unroll
    for (int o = 1; o < 64; o <<= 1) v += __shfl_xor(v, o);
    return v;
}
__device__ __forceinline__ float sigmoidf_(float x) { return 1.0f / (1.0f + __expf(-x)); }
__device__ __forceinline__ float siluf_(float x) { return x / (1.0f + __expf(-x)); }
__device__ __forceinline__ float geluf_(float x) { const float z = 0.7978845608028654f * (x + 0.044715f * x * x * x); return x / (1.0f + __expf(-2.0f * z)); }
#define LDS_WAIT() asm volatile("s_waitcnt lgkmcnt(0)" ::: "memory")
#define VM_WAIT() asm volatile("s_waitcnt vmcnt(0)" ::: "memory")

__device__ __forceinline__ int mod_row(int row) { return row < TL ? (row >> 11) : 4; }

namespace pg8 {
constexpr int BM = 256, BK = 64, HALF = 128, HTB = HALF * BK * 2, STAGE_BYTES = 8 * HTB;
__host__ __device__ __forceinline__ int lds_byte(int r, int c) { const int st = (r >> 4) * 2 + (c >> 5), rr = r & 15, cc = c & 31, ob = rr * 64 + cc * 2; return st * 1024 + (ob ^ (((ob >> 9) & 1) << 5)); }
__host__ __device__ __forceinline__ void stage_rc(int b, int& R, int& C) { const int st = b / 1024, sb = b % 1024, swz = sb ^ (((sb >> 9) & 1) << 5); R = (st >> 1) * 16 + swz / 64; C = (st & 1) * 32 + (swz % 64) / 2; }

struct Unit { int pm, pn, z, rb, cnt; };

template <class Epi, class Sched, bool GATHER>
__device__ __forceinline__ void gemm_phase(LAS unsigned char* lds, const int K, const Sched& S, const Epi& E) {
    int tid_l = threadIdx.x; asm volatile("" : "+v"(tid_l));
    const int tid = tid_l, wid = __builtin_amdgcn_readfirstlane(tid >> 6), lane = tid & 63, wr = wid >> 2, wc = wid & 3, fr = lane & 15, fq = lane >> 4;
    const int nt = K / BK;
    unsigned voffA[2], voffB[2]; int sR[2], sC[2];
#pragma unroll
    for (int i = 0; i < 2; ++i) { int R, C; stage_rc(tid * 16 + i * 8192, R, C); sR[i] = R; sC[i] = C; voffA[i] = (unsigned)(R * K + C) * 2u; voffB[i] = voffA[i]; }
    const size_t kstep = (size_t)(BK * 2);
    const size_t hstep = (size_t)HALF * K * 2;
    const unsigned ldsw = (unsigned)wid * 1024u;
    const int aoff = lds_byte(wr * 64 + fr, fq * 8), boff = lds_byte(wc * 32 + fr, fq * 8);
#define PG8_SA(b, h) (((b) * 2 + (h)) * HTB)
#define PG8_SB(b, h) ((4 + (b) * 2 + (h)) * HTB)
#define PG8_STAGE(bufoff, gbase, voff) do { _Pragma("unroll") for (int _i = 0; _i < 2; ++_i) \
        __builtin_amdgcn_global_load_lds((const unsigned*)((const char*)(gbase) + (voff)[_i]), (LAS unsigned*)(lds + (bufoff) + ldsw + _i * 8192), 16, 0, 0); } while (0)
#define PG8_STAGE_A(bufoff, gbase, h, go) do { if constexpr (GATHER) { PG8_STAGE(bufoff, gbase, (go)[h]); } else { PG8_STAGE(bufoff, (gbase) + (h) * hstep, voffA); } } while (0)
#define PG8_LDA(dst, b, h) do { _Pragma("unroll") for (int m = 0; m < 4; ++m) _Pragma("unroll") for (int k = 0; k < 2; ++k) dst[m][k] = *(const LAS bf16x8*)(lds + PG8_SA(b, h) + aoff + m * 2048 + k * 1024); } while (0)
#define PG8_LDB(dst, b, h) do { _Pragma("unroll") for (int n = 0; n < 2; ++n) _Pragma("unroll") for (int k = 0; k < 2; ++k) dst[n][k] = *(const LAS bf16x8*)(lds + PG8_SB(b, h) + boff + n * 2048 + k * 1024); } while (0)
#define PG8_MMA(ai, bj, At, Bt) do { __builtin_amdgcn_s_setprio(1); _Pragma("unroll") for (int m = 0; m < 4; ++m) _Pragma("unroll") for (int n = 0; n < 2; ++n) _Pragma("unroll") for (int k = 0; k < 2; ++k) \
        acc[ai][bj][m][n] = __builtin_amdgcn_mfma_f32_16x16x32_bf16(Bt[n][k], At[m][k], acc[ai][bj][m][n], 0, 0, 0); __builtin_amdgcn_s_setprio(0); } while (0)
#define PG8_WAIT_V(n) asm volatile("s_waitcnt vmcnt(" #n ")" ::: "memory")
#define PG8_WAIT_L(n) asm volatile("s_waitcnt lgkmcnt(" #n ")" ::: "memory")
#define PG8_BAR __builtin_amdgcn_s_barrier()
#define PG8_SCHED __builtin_amdgcn_sched_barrier(0)
    Unit cur, nxt; int ui = 0;
    if (!S.next(0, cur)) return;
    f32x4 acc[2][2][4][2];
#pragma unroll
    for (int a = 0; a < 2; ++a)
#pragma unroll
        for (int b = 0; b < 2; ++b)
#pragma unroll
            for (int m = 0; m < 4; ++m)
#pragma unroll
                for (int n = 0; n < 2; ++n) acc[a][b][m][n] = (f32x4){0.f, 0.f, 0.f, 0.f};
    bf16x8 At[4][2], B0[2][2], B1[2][2];
    unsigned goC[2][2], goN[2][2];
    if constexpr (GATHER) S.a_offs(cur, sR, sC, K, goC); else { goC[0][0] = goC[0][1] = goC[1][0] = goC[1][1] = 0u; }
    const char* cA = S.a_base(cur); const char* cB = S.b_base(cur);
    PG8_STAGE(PG8_SB(0, 0), cB, voffB); PG8_STAGE(PG8_SB(0, 1), cB + hstep, voffB); PG8_STAGE_A(PG8_SA(0, 0), cA, 0, goC); PG8_STAGE_A(PG8_SA(0, 1), cA, 1, goC);
    if (wr == 1) PG8_BAR;
    PG8_WAIT_V(2); PG8_BAR;
    PG8_STAGE(PG8_SB(1, 0), cB + kstep, voffB); PG8_STAGE_A(PG8_SA(1, 0), cA + kstep, 0, goC); PG8_STAGE(PG8_SB(1, 1), cB + hstep + kstep, voffB);
    PG8_WAIT_V(6); PG8_BAR;
    for (;;) {
        const bool has_next = S.next(ui + 1, nxt);
        const char* nA = has_next ? S.a_base(nxt) : cA; const char* nB = has_next ? S.b_base(nxt) : cB;
        if constexpr (GATHER) { if (has_next) S.a_offs(nxt, sR, sC, K, goN); else { goN[0][0] = goC[0][0]; goN[0][1] = goC[0][1]; goN[1][0] = goC[1][0]; goN[1][1] = goC[1][1]; } }
        for (int t = 0; t < nt; t += 2) {
            const bool last = (t == nt - 2);
            const char* a1 = cA + (size_t)(t + 1) * kstep;
            const char* a2 = last ? nA : cA + (size_t)(t + 2) * kstep; const char* b2 = last ? nB : cB + (size_t)(t + 2) * kstep;
            const char* a3 = a2 + kstep; const char* b3 = b2 + kstep;
            unsigned goL[2][2];
            if constexpr (GATHER) { goL[0][0] = last ? goN[0][0] : goC[0][0]; goL[0][1] = last ? goN[0][1] : goC[0][1]; goL[1][0] = last ? goN[1][0] : goC[1][0]; goL[1][1] = last ? goN[1][1] : goC[1][1]; }
            PG8_LDB(B0, 0, 0); PG8_LDB(B1, 0, 1); PG8_SCHED; PG8_LDA(At, 0, 0); PG8_STAGE_A(PG8_SA(1, 1), a1, 1, goC);
            PG8_WAIT_V(8); PG8_WAIT_L(0); PG8_BAR; PG8_MMA(0, 0, At, B0); PG8_MMA(0, 1, At, B1); PG8_BAR; PG8_SCHED;
            PG8_LDA(At, 0, 1); PG8_STAGE(PG8_SB(0, 0), b2, voffB); PG8_STAGE(PG8_SB(0, 1), b2 + hstep, voffB); PG8_STAGE_A(PG8_SA(0, 0), a2, 0, goL);
            PG8_WAIT_V(8); PG8_WAIT_L(0); PG8_BAR; PG8_MMA(1, 0, At, B0); PG8_MMA(1, 1, At, B1); PG8_BAR; PG8_SCHED;
            PG8_LDB(B0, 1, 0); PG8_LDB(B1, 1, 1); PG8_SCHED; PG8_LDA(At, 1, 0); PG8_STAGE_A(PG8_SA(0, 1), a2, 1, goL);
            PG8_WAIT_V(8); PG8_WAIT_L(0); PG8_BAR; PG8_MMA(0, 0, At, B0); PG8_MMA(0, 1, At, B1); PG8_BAR; PG8_SCHED;
            PG8_LDA(At, 1, 1); PG8_STAGE(PG8_SB(1, 0), b3, voffB); PG8_STAGE(PG8_SB(1, 1), b3 + hstep, voffB); PG8_STAGE_A(PG8_SA(1, 0), a3, 0, goL);
            PG8_WAIT_V(8); PG8_WAIT_L(0); PG8_BAR; PG8_MMA(1, 0, At, B0); PG8_MMA(1, 1, At, B1); PG8_BAR; PG8_SCHED;
        }
        if (wr == 0) PG8_BAR;
        E(acc, cur, wr, wc, fr, fq);
        if (!has_next) break;
#pragma unroll
        for (int a = 0; a < 2; ++a)
#pragma unroll
            for (int b = 0; b < 2; ++b)
#pragma unroll
                for (int m = 0; m < 4; ++m)
#pragma unroll
                    for (int n = 0; n < 2; ++n) acc[a][b][m][n] = (f32x4){0.f, 0.f, 0.f, 0.f};
        cur = nxt; cA = nA; cB = nB; ++ui;
        if constexpr (GATHER) { goC[0][0] = goN[0][0]; goC[0][1] = goN[0][1]; goC[1][0] = goN[1][0]; goC[1][1] = goN[1][1]; }
        if (wr == 1) PG8_BAR;
    }
    PG8_WAIT_V(0);
    PG8_BAR;
#undef PG8_SA
#undef PG8_SB
#undef PG8_STAGE
#undef PG8_STAGE_A
#undef PG8_LDA
#undef PG8_LDB
#undef PG8_MMA
#undef PG8_WAIT_V
#undef PG8_WAIT_L
#undef PG8_BAR
#undef PG8_SCHED
}
}
using pg8::Unit;

__device__ __forceinline__ int xcd_remap(int L, int n) { const int q = n / 8, r = n % 8, x = L % 8, off = L / 8; return (x < r ? x * (q + 1) : r * (q + 1) + (x - r) * q) + off; }

struct SchedWin {
    const bf16_t* A; const bf16_t* Bt; int nM, extra, G, c;
    __device__ __forceinline__ bool next(int i, Unit& u) const {
        const int nmain = nM * NTIN, total = nmain + extra; const int L = i * G + c; if (L >= total) return false;
        const int id = xcd_remap(L, total); u.z = 0; u.rb = 0; u.cnt = 0;
        if (id < nmain) { const int nig = 8 * NTIN, gid = id / nig, fm = gid * 8, gsz = (nM - fm) < 8 ? (nM - fm) : 8; u.pm = fm + ((id % nig) % gsz); u.pn = (id % nig) / gsz; }
        else { u.pm = 32 + (id - nmain); u.pn = 2; }
        return true;
    }
    __device__ __forceinline__ const char* a_base(const Unit& u) const { return (const char*)A + (size_t)u.pm * 256 * D * 2; }
    __device__ __forceinline__ const char* b_base(const Unit& u) const { return (const char*)Bt + (size_t)u.pn * 256 * D * 2; }
    __device__ __forceinline__ void a_offs(const Unit&, const int (&)[2], const int (&)[2], int, unsigned (&)[2][2]) const {}
};
struct SchedBranch {
    const bf16_t* Y; const bf16_t* Wb; int nM, G, c;
    __device__ __forceinline__ bool next(int i, Unit& u) const {
        const int ng = nM * 8; const int L = (i >> 2) * G + c; if (L >= ng) return false;
        const int id = xcd_remap(L, ng); u.pm = id >> 3; u.pn = id & 7; u.z = i & 3; u.rb = 0; u.cnt = 0; return true;
    }
    __device__ __forceinline__ const char* a_base(const Unit& u) const { return (const char*)Y + ((size_t)u.z * TT + (size_t)u.pm * 256) * BW * 2; }
    __device__ __forceinline__ const char* b_base(const Unit& u) const { return (const char*)Wb + ((size_t)u.z * D + (size_t)u.pn * 256) * BW * 2; }
    __device__ __forceinline__ void a_offs(const Unit&, const int (&)[2], const int (&)[2], int, unsigned (&)[2][2]) const {}
};
struct SchedOut {
    const bf16_t* A; const bf16_t* Bt; int nM, G, c;
    __device__ __forceinline__ bool next(int i, Unit& u) const {
        const int nu = nM * 8; const int L = i * G + c; if (L >= nu) return false;
        const int id = xcd_remap(L, nu); u.pm = id >> 3; u.pn = id & 7; u.z = 0; u.rb = 0; u.cnt = 0; return true;
    }
    __device__ __forceinline__ const char* a_base(const Unit& u) const { return (const char*)A + (size_t)u.pm * 256 * D * 2; }
    __device__ __forceinline__ const char* b_base(const Unit& u) const { return (const char*)Bt + (size_t)u.pn * 256 * D * 2; }
    __device__ __forceinline__ void a_offs(const Unit&, const int (&)[2], const int (&)[2], int, unsigned (&)[2][2]) const {}
};
constexpr int ULIST_OFF = LDSCTL_OFF + 1024;
__device__ __forceinline__ void moe_build_list(LAS unsigned char* lds, const unsigned* cw, int G, int c, int tid) {
    if (tid < 8) {
        int cnt[NE]; int tp = 0;
#pragma unroll
        for (int e = 0; e < NE; ++e) { cnt[e] = (int)__hip_atomic_load(cw + e, __ATOMIC_RELAXED, __HIP_MEMORY_SCOPE_AGENT); tp += (cnt[e] + 255) >> 8; }
        const int total = tp * 8; const int L = tid * G + c;
        int pm = -1, pn = 0, z = 0, rb = 0, cn = 0;
        if (L < total) {
            const int id = xcd_remap(L, total); int acc = 0;
#pragma unroll
            for (int e = 0; e < NE; ++e) { const int p = (cnt[e] + 255) >> 8; if (id >= acc * 8 && id < (acc + p) * 8) { const int r = id - acc * 8; pn = r / p; pm = r % p; z = e; rb = acc * 256; cn = cnt[e]; } acc += p; }
        }
        LAS int* ul = (LAS int*)(lds + ULIST_OFF) + tid * 8;
        ul[0] = pm; ul[1] = pn; ul[2] = z; ul[3] = rb; ul[4] = cn;
    }
    __syncthreads();
}
template <bool UP>
struct SchedMoe {
    LAS unsigned char* lds; const bf16_t* A; const bf16_t* W; const int* LT;
    __device__ __forceinline__ bool next(int i, Unit& u) const {
        if (i >= 8) return false;
        const LAS int* ul = (const LAS int*)(lds + ULIST_OFF) + i * 8;
        const int pm = __builtin_amdgcn_readfirstlane(ul[0]); if (pm < 0) return false;
        u.pm = pm; u.pn = __builtin_amdgcn_readfirstlane(ul[1]); u.z = __builtin_amdgcn_readfirstlane(ul[2]); u.rb = __builtin_amdgcn_readfirstlane(ul[3]); u.cnt = __builtin_amdgcn_readfirstlane(ul[4]); return true;
    }
    __device__ __forceinline__ const char* a_base(const Unit& u) const { return UP ? (const char*)A : (const char*)A + ((size_t)u.rb + (size_t)u.pm * 256) * DFF * 2; }
    __device__ __forceinline__ const char* b_base(const Unit& u) const { return UP ? (const char*)W + ((size_t)u.z * D + (size_t)u.pn * 256) * D * 2 : (const char*)W + ((size_t)u.z * D + (size_t)u.pn * 256) * DFF * 2; }
    __device__ __forceinline__ void a_offs(const Unit& u, const int (&R)[2], const int (&C)[2], int K, unsigned (&o)[2][2]) const {
#pragma unroll
        for (int h = 0; h < 2; ++h)
#pragma unroll
            for (int i = 0; i < 2; ++i) { const int slot = u.pm * 256 + h * 128 + R[i]; int tok = 0; if (slot < u.cnt) tok = LT[(size_t)u.z * TT + slot] >> 1; o[h][i] = (unsigned)(tok * K + C[i]) * 2u; }
    }
};

struct EpiWin {
    unsigned char* ws; const float* rope;
    __device__ __forceinline__ void operator()(const f32x4 (&acc)[2][2][4][2], const Unit& u, int wr, int wc, int fr, int fq) const {
        const int row0 = u.pm * 256 + wr * 64 + fr; const int pn = u.pn; const int cw = wc * 32 + 4 * fq;
        if (pn <= 2) {
            const bool latent = u.pm < 32; const int half = wc & 1;
            bf16_t* Q = (bf16_t*)(ws + WS_Q); bf16_t* KV = (bf16_t*)(ws + WS_K);
#pragma unroll
            for (int ai = 0; ai < 2; ++ai)
#pragma unroll
                for (int m = 0; m < 4; ++m) {
                    const int row = row0 + ai * 128 + m * 16;
                    f32x4 cs = (f32x4){1.f, 1.f, 1.f, 1.f}, sn = (f32x4){0.f, 0.f, 0.f, 0.f};
                    if (latent) { const int t = row & 2047; const int p = half ? (t & 63) : (t >> 6); cs = *(const f32x4*)(rope + p * 32 + 4 * fq); sn = *(const f32x4*)(rope + p * 32 + 16 + 4 * fq); }
#pragma unroll
                    for (int bj = 0; bj < 2; ++bj) {
                        const f32x4 x1 = acc[ai][bj][m][0], x2 = acc[ai][bj][m][1];
                        if (pn < 2) {
                            const f32x4 o1 = (x1 * cs - x2 * sn) * QSCALE, o2 = (x2 * cs + x1 * sn) * QSCALE;
                            bf16_t* p = Q + (size_t)row * BW + pn * 256 + bj * 128 + cw;
                            *(u32x2*)p = f32_to_bf4(o1); *(u32x2*)(p + 16) = f32_to_bf4(o2);
                        } else if (bj == 0) {
                            const f32x4 o1 = x1 * cs - x2 * sn, o2 = x2 * cs + x1 * sn;
                            bf16_t* p = KV + (size_t)row * 128 + cw;
                            *(u32x2*)p = f32_to_bf4(o1); *(u32x2*)(p + 16) = f32_to_bf4(o2);
                        } else {
                            bf16_t* p = KV + (size_t)TT * 128 + (size_t)row * 128 + cw;
                            *(u32x2*)p = f32_to_bf4(x1); *(u32x2*)(p + 16) = f32_to_bf4(x2);
                        }
                    }
                    asm volatile("" ::: "memory");
                }
        } else if (pn <= 8) {
            bf16_t* O = (bf16_t*)(ws + WS_GU) + (size_t)((pn - 3) >> 1) * TT * BW; const int ct = ((pn - 3) & 1) * 256; const bool act = pn <= 6;
#pragma unroll
            for (int ai = 0; ai < 2; ++ai)
#pragma unroll
                for (int m = 0; m < 4; ++m) { const int row = row0 + ai * 128 + m * 16;
#pragma unroll
                    for (int bj = 0; bj < 2; ++bj)
#pragma unroll
                        for (int n = 0; n < 2; ++n) { f32x4 v = acc[ai][bj][m][n];
                            if (act) { v[0] = geluf_(v[0]); v[1] = geluf_(v[1]); v[2] = geluf_(v[2]); v[3] = geluf_(v[3]); }
                            *(u32x2*)(O + (size_t)row * BW + ct + bj * 128 + cw + 16 * n) = f32_to_bf4(v); }
                    asm volatile("" ::: "memory"); }
        } else if (pn <= 16) {
            const bool glu = pn >= 13; bf16_t* O = (bf16_t*)(ws + WS_CU) + (glu ? (size_t)TT * BW : (size_t)0); const int ct = ((pn - 9) & 3) * 128;
#pragma unroll
            for (int ai = 0; ai < 2; ++ai)
#pragma unroll
                for (int m = 0; m < 4; ++m) { const int row = row0 + ai * 128 + m * 16;
#pragma unroll
                    for (int n = 0; n < 2; ++n) { const f32x4 a = acc[ai][0][m][n], b = acc[ai][1][m][n]; f32x4 v;
                        if (glu) { v[0] = a[0] * sigmoidf_(b[0]); v[1] = a[1] * sigmoidf_(b[1]); v[2] = a[2] * sigmoidf_(b[2]); v[3] = a[3] * sigmoidf_(b[3]); } else v = a * b;
                        *(u32x2*)(O + (size_t)row * BW + ct + cw + 16 * n) = f32_to_bf4(v); }
                    asm volatile("" ::: "memory"); }
        } else {
            bf16_t* G = (bf16_t*)(ws + WS_G); const int ct = (pn - 17) * 256;
#pragma unroll
            for (int ai = 0; ai < 2; ++ai)
#pragma unroll
                for (int m = 0; m < 4; ++m) { const int row = row0 + ai * 128 + m * 16;
#pragma unroll
                    for (int bj = 0; bj < 2; ++bj)
#pragma unroll
                        for (int n = 0; n < 2; ++n) { f32x4 v = acc[ai][bj][m][n]; v[0] = sigmoidf_(v[0]); v[1] = sigmoidf_(v[1]); v[2] = sigmoidf_(v[2]); v[3] = sigmoidf_(v[3]);
                            *(u32x2*)(G + (size_t)row * 8192 + ct + bj * 128 + cw + 16 * n) = f32_to_bf4(v); }
                    asm volatile("" ::: "memory"); }
        }
    }
};
struct EpiBranch {
    const bf16_t* G; float* MS; bf16_t* MG;
    __device__ __forceinline__ void operator()(const f32x4 (&acc)[2][2][4][2], const Unit& u, int wr, int wc, int fr, int fq) const {
        const int row0 = u.pm * 256 + wr * 64 + fr; const int cw = wc * 32 + 4 * fq; const int z = u.z;
        f32x4* ms = (f32x4*)MS + threadIdx.x; asm volatile("" : "+v"(ms));
#pragma unroll
        for (int ai = 0; ai < 2; ++ai)
#pragma unroll
            for (int m = 0; m < 4; ++m) { const int row = row0 + ai * 128 + m * 16;
#pragma unroll
                for (int bj = 0; bj < 2; ++bj)
#pragma unroll
                    for (int n = 0; n < 2; ++n) {
                        const int col = u.pn * 256 + bj * 128 + cw + 16 * n; const int slot = ((ai * 4 + m) * 2 + bj) * 2 + n;
                        const f32x4 g = bf4_to_f32(*(const u32x2*)(G + (size_t)row * 8192 + z * 2048 + col));
                        f32x4 v = acc[ai][bj][m][n] * g;
                        if (z > 0) v += ms[slot * 512];
                        if (z < 3) ms[slot * 512] = v; else *(u32x2*)(MG + (size_t)row * D + col) = f32_to_bf4(v);
                    }
                asm volatile("" ::: "memory"); }
    }
};
struct EpiOut {
    const float* srcL; const float* srcC; float* XS; const float* g1;
    __device__ __forceinline__ void operator()(const f32x4 (&acc)[2][2][4][2], const Unit& u, int wr, int wc, int fr, int fq) const {
        const int row0 = u.pm * 256 + wr * 64 + fr; const int cw = wc * 32 + 4 * fq;
        const int mr = u.pm < 32 ? (u.pm >> 3) : 4; const float* gp = g1 + (size_t)mr * 12288;
        const float* src = u.pm < 32 ? srcL : srcC - (size_t)TL * D;
        f32x4 gv[2][2];
#pragma unroll
        for (int bj = 0; bj < 2; ++bj)
#pragma unroll
            for (int n = 0; n < 2; ++n) gv[bj][n] = *(const f32x4*)(gp + u.pn * 256 + bj * 128 + cw + 16 * n);
#pragma unroll
        for (int ai = 0; ai < 2; ++ai)
#pragma unroll
            for (int m = 0; m < 4; ++m) { const size_t off = (size_t)(row0 + ai * 128 + m * 16) * D + u.pn * 256 + cw;
#pragma unroll
                for (int bj = 0; bj < 2; ++bj)
#pragma unroll
                    for (int n = 0; n < 2; ++n) { const f32x4 s = *(const f32x4*)(src + off + bj * 128 + 16 * n); *(f32x4*)(XS + off + bj * 128 + 16 * n) = s + gv[bj][n] * acc[ai][bj][m][n]; }
                asm volatile("" ::: "memory"); }
    }
};
struct EpiUp {
    bf16_t* ACT;
    __device__ __forceinline__ void operator()(const f32x4 (&acc)[2][2][4][2], const Unit& u, int wr, int wc, int fr, int fq) const {
        const int row0 = u.rb + u.pm * 256 + wr * 64 + fr; const int cw = wc * 32 + 4 * fq;
#pragma unroll
        for (int ai = 0; ai < 2; ++ai)
#pragma unroll
            for (int m = 0; m < 4; ++m) { const int row = row0 + ai * 128 + m * 16;
#pragma unroll
                for (int n = 0; n < 2; ++n) { const f32x4 a = acc[ai][0][m][n], b = acc[ai][1][m][n]; f32x4 v;
                    v[0] = siluf_(a[0]) * b[0]; v[1] = siluf_(a[1]) * b[1]; v[2] = siluf_(a[2]) * b[2]; v[3] = siluf_(a[3]) * b[3];
                    *(u32x2*)(ACT + (size_t)row * DFF + u.pn * 128 + cw + 16 * n) = f32_to_bf4(v); } }
    }
};
struct EpiDown {
    const int* LT; const float* LW; bf16_t* YT;
    __device__ __forceinline__ void operator()(const f32x4 (&acc)[2][2][4][2], const Unit& u, int wr, int wc, int fr, int fq) const {
        const int s0 = u.pm * 256 + wr * 64 + fr; const int cw = wc * 32 + 4 * fq;
#pragma unroll
        for (int ai = 0; ai < 2; ++ai)
#pragma unroll
            for (int m = 0; m < 4; ++m) { const int slot = s0 + ai * 128 + m * 16;
                if (slot < u.cnt) { const int tj = LT[(size_t)u.z * TT + slot]; const float w = LW[(size_t)u.z * TT + slot];
#pragma unroll
                    for (int bj = 0; bj < 2; ++bj)
#pragma unroll
                        for (int n = 0; n < 2; ++n) *(u32x2*)(YT + (size_t)tj * D + u.pn * 256 + bj * 128 + cw + 16 * n) = f32_to_bf4(acc[ai][bj][m][n] * w); } }
    }
};

#define XB_TMO      128
#define XB_XCNT(j)  (256  + 64 * (j))
#define XB_XSUB(j)  (1280 + 64 * (j))
#define XB_XGEN(j)  (2304 + 64 * (j))
#define XB_TOP      3328
#define XB_TOPGEN   3392
#define XCD_BAR_WORDS 3456
#define XB_SPIN_CAP (1u << 22)
__device__ __forceinline__ unsigned xb_ld(unsigned* p)              { return __hip_atomic_load(p, __ATOMIC_RELAXED, __HIP_MEMORY_SCOPE_AGENT); }
__device__ __forceinline__ unsigned xb_add(unsigned* p, unsigned v) { return __hip_atomic_fetch_add(p, v, __ATOMIC_RELAXED, __HIP_MEMORY_SCOPE_AGENT); }
__device__ __forceinline__ unsigned xb_xcc_id() { return (unsigned)__builtin_amdgcn_s_getreg((3 << 11) | 20) & 0xFu; }
#define XB_SPIN(cond, bar) do { unsigned _sp = 0; while (cond) { __builtin_amdgcn_s_sleep(1); \
    if ((++_sp & 255u) == 0u) { if (xb_ld(&(bar)[XB_TMO])) break; if (_sp > XB_SPIN_CAP) { atomicAdd(&(bar)[XB_TMO], 1u); break; } } } } while (0)
struct XcdBarrier { unsigned* bar; unsigned x; volatile LAS unsigned* st; };
__device__ __forceinline__ XcdBarrier xcd_barrier_post(unsigned* bar, volatile LAS unsigned* st) {
    XcdBarrier b; b.bar = bar; b.x = xb_xcc_id(); b.st = st;
    if (threadIdx.x == 0) (void)xb_add(&bar[XB_XCNT(b.x)], 1u);
    return b;
}
__device__ __forceinline__ void xcd_barrier_complete(unsigned* bar, unsigned x, unsigned& nloc, unsigned& nx) {
    const unsigned G = gridDim.x * gridDim.y * gridDim.z;
    unsigned sum, cnt, mine, sp = 0u;
    for (;;) {
        sum = 0u; cnt = 0u; mine = 0u;
#pragma unroll
        for (unsigned j = 0; j < 16; ++j) { const unsigned c = xb_ld(&bar[XB_XCNT(j)]); sum += c; cnt += (c > 0u) ? 1u : 0u; mine = (j == x) ? c : mine; }
        if (sum == G) break;
        __builtin_amdgcn_s_sleep(1);
        if ((++sp & 255u) == 0u) { if (xb_ld(&bar[XB_TMO])) break; if (sp > XB_SPIN_CAP) { atomicAdd(&bar[XB_TMO], 1u); break; } }
    }
    nloc = mine > 0u ? mine : 1u; nx = cnt > 0u ? cnt : 1u;
}
__device__ __forceinline__ void xcd_barrier(const XcdBarrier& b) {
    asm volatile("s_waitcnt vmcnt(0)" ::: "memory");
    __syncthreads();
    if (threadIdx.x == 0) {
        unsigned* bar = b.bar;
        __builtin_amdgcn_s_waitcnt(0);
        unsigned nloc = b.st[0], nx = b.st[1];
        if (nloc == 0u) { xcd_barrier_complete(bar, b.x, nloc, nx); b.st[0] = nloc; b.st[1] = nx; }
        const unsigned old = xb_add(&bar[XB_XSUB(b.x)], 1u);
        const unsigned gen = old / nloc;
        if (old + 1u == (gen + 1u) * nloc) {
            __builtin_amdgcn_fence(__ATOMIC_RELEASE, "agent");
            asm volatile("s_waitcnt vmcnt(0)" ::: "memory");
            const unsigned og = xb_add(&bar[XB_TOP], 1u);
            const unsigned tg = og / nx;
            if (og + 1u == (tg + 1u) * nx) xb_add(&bar[XB_TOPGEN], 1u);
            else XB_SPIN(xb_ld(&bar[XB_TOPGEN]) == tg, bar);
            __builtin_amdgcn_fence(__ATOMIC_ACQUIRE, "agent");
            xb_add(&bar[XB_XGEN(b.x)], 1u);
            asm volatile("s_waitcnt vmcnt(0)" ::: "memory");
        } else {
            XB_SPIN(xb_ld(&bar[XB_XGEN(b.x)]) == gen, bar);
            __builtin_amdgcn_fence(__ATOMIC_ACQUIRE, "agent");
            asm volatile("s_waitcnt vmcnt(0)" ::: "memory");
        }
    }
    __syncthreads();
}

struct Args { const float* in[26]; float* out; unsigned char* ws; int ph_lo, ph_hi; };
enum { I_X = 0, I_C, I_CTX, I_CCTX, I_ADAW, I_ADAB, I_N1G, I_N2G, I_WIN, I_SINK, I_SLNG, I_SLNB, I_SGUW, I_SGUB, I_SCW, I_CDW, I_CDB, I_CLNG, I_CLNB, I_WBR, I_WOUT, I_RW, I_RB, I_WUP, I_WDN, I_FG };

__device__ __forceinline__ void transpose_item(const float* W, int K, int N, bf16_t* WT, int k0, int s0, int n0, LAS float* scr, int lane) {
#pragma unroll 8
    for (int i = 0; i < 32; ++i) { const int kk = 2 * i + (lane >> 5); scr[kk * 33 + (lane & 31)] = W[(size_t)(k0 + kk) * N + s0 + (lane & 31)]; }
    LDS_WAIT(); asm volatile("" ::: "memory");
    const int c = lane & 7;
#pragma unroll
    for (int j = 0; j < 4; ++j) { const int n = (lane >> 3) + 8 * j; const LAS float* s = scr + (8 * c) * 33 + n;
        u32x4 o; o.x = pk2(s[0 * 33], s[1 * 33]); o.y = pk2(s[2 * 33], s[3 * 33]); o.z = pk2(s[4 * 33], s[5 * 33]); o.w = pk2(s[6 * 33], s[7 * 33]);
        *(u32x4*)(WT + (size_t)(n0 + n) * K + k0 + 8 * c) = o; }
    LDS_WAIT(); asm volatile("" ::: "memory");
}
__device__ __forceinline__ int win_src(int n) {
    const int pn = n >> 8, j = n & 255;
    if (pn < 9) return n;
    if (pn < 13) { const int t = pn - 9; return j < 128 ? 2304 + t * 128 + j : 2816 + t * 128 + (j - 128); }
    if (pn < 17) { const int t = pn - 13; return j < 128 ? 3328 + t * 128 + j : 3840 + t * 128 + (j - 128); }
    return n;
}
__device__ __forceinline__ int up_src(int n) { const int pn = n >> 8, j = n & 255; return j < 128 ? pn * 128 + j : 1024 + pn * 128 + (j - 128); }

__device__ __forceinline__ void p0_prologue(const Args& a, LAS unsigned char* lds, int tid, int lane, int wave, int wg, int G) {
    unsigned char* ws = a.ws;
    if (wg == 0) {
        float* rope = (float*)(ws + WS_ROPE);
        for (int idx = tid; idx < 64 * 16; idx += NTHR) { const int p = idx >> 4, j = idx & 15; const float inv = 1.0f / powf(10000.0f, (float)(2 * j) / 32.0f); const float ang = (float)p * inv; float s, c; sincosf(ang, &s, &c); rope[p * 32 + j] = c; rope[p * 32 + 16 + j] = s; }
    }
    {
        LAS float* SC = (LAS float*)lds;
        LAS float* RED = (LAS float*)(lds + 40960);
        for (int idx = tid; idx < 5 * D; idx += NTHR) { const int r = idx >> 11, k = idx & 2047; const float v = r < 4 ? a.in[I_C][r * D + k] : a.in[I_CCTX][k]; SC[idx] = siluf_(v); }
        __syncthreads();
        float* MOD = (float*)(ws + WS_MOD);
        for (int it = wg; it < 768; it += G) {
            const int l = it / 384, ch = it % 384; const int col = ch * 32 + (lane & 31); const int kp = lane >> 5;
            const float* W = a.in[I_ADAW] + (size_t)l * D * 12288 + col;
            float s0 = 0.f, s1 = 0.f, s2 = 0.f, s3 = 0.f, s4 = 0.f;
#pragma unroll 8
            for (int i = 0; i < 128; ++i) { const int k = wave * 256 + 2 * i + kp; const float w = W[(size_t)k * 12288];
                s0 += SC[k] * w; s1 += SC[2048 + k] * w; s2 += SC[4096 + k] * w; s3 += SC[6144 + k] * w; s4 += SC[8192 + k] * w; }
            s0 += __shfl_xor(s0, 32); s1 += __shfl_xor(s1, 32); s2 += __shfl_xor(s2, 32); s3 += __shfl_xor(s3, 32); s4 += __shfl_xor(s4, 32);
            if (lane < 32) { RED[(wave * 5 + 0) * 32 + lane] = s0; RED[(wave * 5 + 1) * 32 + lane] = s1; RED[(wave * 5 + 2) * 32 + lane] = s2; RED[(wave * 5 + 3) * 32 + lane] = s3; RED[(wave * 5 + 4) * 32 + lane] = s4; }
            __syncthreads();
            if (tid < 160) { const int r = tid >> 5, cc = tid & 31; float s = 0.f;
#pragma unroll
                for (int w = 0; w < 8; ++w) s += RED[(w * 5 + r) * 32 + cc];
                MOD[((size_t)l * 5 + r) * 12288 + ch * 32 + cc] = s + a.in[I_ADAB][l * 12288 + ch * 32 + cc]; }
            __syncthreads();
        }
    }
    {
        LAS float* scr = (LAS float*)(lds + wave * 16384);
        const int gw = wg * NWAVES + wave, NGW = G * NWAVES;
        constexpr int I_IN = 2 * 32 * (NIN / 32), I_BR = 8 * 8 * 64, I_OUT = 2 * 32 * 64, I_UP = 32 * 32 * 64, I_DN = 32 * 16 * 64;
        constexpr int NITEMS = I_IN + I_BR + I_OUT + I_UP + I_DN;
        for (int it = gw; it < NITEMS; it += NGW) {
            int r = it;
            if (r < I_IN) { const int per = 32 * (NIN / 32); const int l = r / per; r %= per; const int kb = r / (NIN / 32), nb = r % (NIN / 32);
                transpose_item(a.in[I_WIN] + (size_t)l * D * NIN, D, NIN, (bf16_t*)(ws + WS_WIN) + (size_t)l * NIN * D, kb * 64, win_src(nb * 32), nb * 32, scr, lane); continue; }
            r -= I_IN;
            if (r < I_BR) { const int mz = r / 512; r %= 512; const int kb = r / 64, nb = r % 64;
                transpose_item(a.in[I_WBR] + (size_t)mz * BW * D, BW, D, (bf16_t*)(ws + WS_WB) + (size_t)mz * D * BW, kb * 64, nb * 32, nb * 32, scr, lane); continue; }
            r -= I_BR;
            if (r < I_OUT) { const int l = r / 2048; r %= 2048; const int kb = r / 64, nb = r % 64;
                transpose_item(a.in[I_WOUT] + (size_t)l * D * D, D, D, (bf16_t*)(ws + WS_WO) + (size_t)l * D * D, kb * 64, nb * 32, nb * 32, scr, lane); continue; }
            r -= I_OUT;
            if (r < I_UP) { const int le = r / 2048; r %= 2048; const int kb = r / 64, nb = r % 64;
                transpose_item(a.in[I_WUP] + (size_t)le * D * D, D, D, (bf16_t*)(ws + WS_WUP) + (size_t)le * D * D, kb * 64, up_src(nb * 32), nb * 32, scr, lane); continue; }
            r -= I_UP;
            { const int le = r / 1024; r %= 1024; const int kb = r / 64, nb = r % 64;
                transpose_item(a.in[I_WDN] + (size_t)le * DFF * D, DFF, D, (bf16_t*)(ws + WS_WDN) + (size_t)le * D * DFF, kb * 64, nb * 32, nb * 32, scr, lane); }
        }
    }
}

template <int MODE>
__device__ __forceinline__ void norm_phase(const Args& a, int lane, int wave, int wg, int G) {
    unsigned char* ws = a.ws;
    const float* MOD = (const float*)(ws + WS_MOD);
    float* XS = (float*)(ws + WS_XS); bf16_t* H = (bf16_t*)(ws + WS_H); const bf16_t* YT = (const bf16_t*)(ws + WS_YT);
    const int nrows = MODE == 2 ? TL : TT;
    const int gw = wg * NWAVES + wave, NGW = G * NWAVES;
    for (int row = gw; row < nrows; row += NGW) {
        const int mr = mod_row(row);
        const float* src = MODE == 0 ? (row < TL ? a.in[I_X] + (size_t)row * D : a.in[I_CTX] + (size_t)(row - TL) * D) : XS + (size_t)row * D;
        f32x4 x[8]; float ss = 0.f;
#pragma unroll
        for (int j = 0; j < 8; ++j) x[j] = *(const f32x4*)(src + 256 * j + 4 * lane);
        if (MODE != 0) {
            const float* g2 = MOD + ((size_t)0 * 5 + mr) * 12288 + 10240;
            const float* g2p = MODE == 1 ? g2 : g2 + (size_t)5 * 12288;
#pragma unroll
            for (int j = 0; j < 8; ++j) {
                const f32x4 y0 = bf4_to_f32(*(const u32x2*)(YT + (size_t)(2 * row) * D + 256 * j + 4 * lane)), y1 = bf4_to_f32(*(const u32x2*)(YT + (size_t)(2 * row + 1) * D + 256 * j + 4 * lane));
                const f32x4 g = *(const f32x4*)(g2p + 256 * j + 4 * lane);
                x[j] += g * (y0 + y1);
            }
            if (MODE == 1) {
#pragma unroll
                for (int j = 0; j < 8; ++j) *(f32x4*)(XS + (size_t)row * D + 256 * j + 4 * lane) = x[j];
            }
        }
#pragma unroll
        for (int j = 0; j < 8; ++j) ss += (x[j][0] * x[j][0] + x[j][1] * x[j][1]) + (x[j][2] * x[j][2] + x[j][3] * x[j][3]);
        const float rstd = 1.0f / sqrtf(wave_sum(ss) * (1.0f / D) + 1e-6f);
        if (MODE == 2) {
#pragma unroll
            for (int j = 0; j < 8; ++j) { const f32x4 g = *(const f32x4*)(a.in[I_FG] + 256 * j + 4 * lane); *(f32x4*)(a.out + (size_t)row * D + 256 * j + 4 * lane) = x[j] * rstd * g; }
        } else {
            const int l = MODE;
            const float* m = MOD + ((size_t)l * 5 + mr) * 12288; const float* gn = a.in[I_N1G] + (size_t)l * D;
#pragma unroll
            for (int j = 0; j < 8; ++j) { const int c = 256 * j + 4 * lane; const f32x4 g = *(const f32x4*)(gn + c), sh = *(const f32x4*)(m + c), sc = *(const f32x4*)(m + 2048 + c);
                const f32x4 h = x[j] * rstd * g * (sc + 1.0f) + sh; *(u32x2*)(H + (size_t)row * D + c) = f32_to_bf4(h); }
        }
    }
}

__device__ __forceinline__ void router_phase(const Args& a, int l, LAS unsigned char* lds, int tid, int lane, int wave, int wg, int G) {
    unsigned char* ws = a.ws;
    constexpr int RWS = 2052;
    LAS float* RWT = (LAS float*)lds;
    LAS int* RE = (LAS int*)(lds + 16 * RWS * 4);
    LAS float* RWGT = (LAS float*)(lds + 16 * RWS * 4 + 512);
    LAS int* RBASE = (LAS int*)(lds + 16 * RWS * 4 + 1024);
    const int nrows = l == 0 ? TT : TL; const int rpw = nrows / G;
    for (int idx = tid; idx < D * NE; idx += NTHR) { const int k = idx >> 4, e = idx & 15; RWT[e * RWS + k] = a.in[I_RW][idx]; }
    __syncthreads();
    const float* MOD = (const float*)(ws + WS_MOD) + (size_t)l * 5 * 12288;
    const float* XS = (const float*)(ws + WS_XS); bf16_t* H = (bf16_t*)(ws + WS_H); const float* gn = a.in[I_N2G] + (size_t)l * D;
    for (int rl = wave; rl < rpw; rl += NWAVES) {
        const int row = wg * rpw + rl; const int mr = mod_row(row); const float* m = MOD + (size_t)mr * 12288;
        f32x4 x[8]; float ss = 0.f;
#pragma unroll
        for (int j = 0; j < 8; ++j) { x[j] = *(const f32x4*)(XS + (size_t)row * D + 256 * j + 4 * lane); ss += (x[j][0] * x[j][0] + x[j][1] * x[j][1]) + (x[j][2] * x[j][2] + x[j][3] * x[j][3]); }
        const float rstd = 1.0f / sqrtf(wave_sum(ss) * (1.0f / D) + 1e-6f);
#pragma unroll
        for (int j = 0; j < 8; ++j) { const int c = 256 * j + 4 * lane; const f32x4 g = *(const f32x4*)(gn + c), sh = *(const f32x4*)(m + 6144 + c), sc = *(const f32x4*)(m + 8192 + c);
            x[j] = x[j] * rstd * g * (sc + 1.0f) + sh; *(u32x2*)(H + (size_t)row * D + c) = f32_to_bf4(x[j]); }
        float lg[NE];
#pragma unroll
        for (int e = 0; e < NE; ++e) { float s = 0.f;
#pragma unroll
            for (int j = 0; j < 8; ++j) { const f32x4 w = *(const LAS f32x4*)(RWT + e * RWS + 256 * j + 4 * lane); s += (x[j][0] * w[0] + x[j][1] * w[1]) + (x[j][2] * w[2] + x[j][3] * w[3]); }
            lg[e] = wave_sum(s); }
        float mx = lg[0];
#pragma unroll
        for (int e = 1; e < NE; ++e) mx = fmaxf(mx, lg[e]);
        float sc_[NE], den = 0.f;
#pragma unroll
        for (int e = 0; e < NE; ++e) { sc_[e] = expf(lg[e] - mx); den += sc_[e]; }
        float bi[NE];
#pragma unroll
        for (int e = 0; e < NE; ++e) { sc_[e] = sc_[e] / den; bi[e] = sc_[e] + a.in[I_RB][e]; }
        float bestg = -3.0e38f; int gsel = 0;
#pragma unroll
        for (int g = 0; g < 4; ++g) { float m1 = -3.0e38f, m2 = -3.0e38f;
#pragma unroll
            for (int q = 0; q < 4; ++q) { const float v = bi[g * 4 + q]; if (v > m1) { m2 = m1; m1 = v; } else if (v > m2) m2 = v; }
            const float gs = m1 + m2; if (gs > bestg) { bestg = gs; gsel = g; } }
        float b0 = -3.0e38f, b1 = -3.0e38f, s0 = 0.f, s1 = 0.f; int i0 = 0, i1 = 0;
#pragma unroll
        for (int e = 0; e < NE; ++e) if ((e >> 2) == gsel) { const float v = bi[e];
            if (v > b0) { b1 = b0; i1 = i0; s1 = s0; b0 = v; i0 = e; s0 = sc_[e]; } else if (v > b1) { b1 = v; i1 = e; s1 = sc_[e]; } }
        if (lane == 0) { RE[rl * 2] = i0; RE[rl * 2 + 1] = i1; const float inv = 1.0f / (s0 + s1); RWGT[rl * 2] = s0 * inv; RWGT[rl * 2 + 1] = s1 * inv; }
    }
    __syncthreads();
    unsigned* cw = (unsigned*)(ws + WS_CTL) + CW_CNT + 64 * l;
    if (tid < NE) { int n = 0; for (int i = 0; i < 2 * rpw; ++i) n += (RE[i] == tid) ? 1 : 0; RBASE[tid] = n ? (int)__hip_atomic_fetch_add(cw + tid, (unsigned)n, __ATOMIC_RELAXED, __HIP_MEMORY_SCOPE_AGENT) : 0; }
    __syncthreads();
    if (tid < 2 * rpw) { const int e = RE[tid]; int rank = RBASE[e]; for (int i = 0; i < tid; ++i) rank += (RE[i] == e) ? 1 : 0;
        const int row = wg * rpw + (tid >> 1);
        ((int*)(ws + WS_LT))[(size_t)e * TT + rank] = row * 2 + (tid & 1); ((float*)(ws + WS_LW))[(size_t)e * TT + rank] = RWGT[tid]; }
    __syncthreads();
}

__device__ __forceinline__ void attn_unit(const Args& a, int l, int u, LAS unsigned char* lds, int tid, int lane, int wave) {
    unsigned char* ws = a.ws;
    const bf16_t* Q = (const bf16_t*)(ws + WS_Q); const bf16_t* KB = (const bf16_t*)(ws + WS_K); const bf16_t* VB = (const bf16_t*)(ws + WS_V);
    bf16_t* YA = (bf16_t*)(ws + WS_Y);
    constexpr int KS = 72, VS = 136;
    LAS bf16_t* KL = (LAS bf16_t*)lds;
    LAS bf16_t* VT = (LAS bf16_t*)(lds + 128 * KS * 2);
    int b, g, hp, qrow0, nb = 0; bool isctx;
    if (u < 256) { hp = u & 1; g = (u >> 1) & 1; nb = (u >> 2) & 15; b = u >> 6; qrow0 = b * SEQ + nb * 128; isctx = false; }
    else { const int v = u - 256; hp = v & 1; g = (v >> 1) & 1; const int cb = (v >> 2) & 1; b = v >> 3; qrow0 = TL + b * LCTX + cb * 128; isctx = true; }
    const int head = g * 4 + hp * 2 + (wave >> 2); const int qi = (wave & 3) * 32 + (lane & 31); const int hh = lane >> 5;
    const int qrow = qrow0 + qi;
    bf16x8 qf[4];
#pragma unroll
    for (int s = 0; s < 4; ++s) qf[s] = *(const bf16x8*)(Q + (size_t)qrow * BW + head * 64 + 16 * s + 8 * hh);
    const float sink2 = a.in[I_SINK][l * 8 + head] * LOG2E;
    float mrun = sink2, lrun = (lane < 32) ? 1.0f : 0.0f;
    f32x16 o0, o1;
#pragma unroll
    for (int r = 0; r < 16; ++r) { o0[r] = 0.f; o1[r] = 0.f; }
    for (int ch = 0; ch < 5; ++ch) {
        int krow0, mask = 0;
        if (ch < 3) { if (isctx) continue; const int kb = nb - 1 + ch; if (kb < 0 || kb > 15) continue; krow0 = b * SEQ + kb * 128; mask = ch == 0 ? 1 : (ch == 2 ? 2 : 0); }
        else krow0 = TL + b * LCTX + (ch - 3) * 128;
        __syncthreads();
#pragma unroll
        for (int i = 0; i < 2; ++i) { const int p = tid + 512 * i; const int key = p >> 3, seg = p & 7;
            const u32x4 kv = *(const u32x4*)(KB + (size_t)(krow0 + key) * 128 + g * 64 + seg * 8);
            *(LAS u32x4*)(KL + key * KS + seg * 8) = kv;
            const u32x4 vv = *(const u32x4*)(VB + (size_t)(krow0 + key) * 128 + g * 64 + seg * 8);
            VT[(seg * 8 + 0) * VS + key] = (bf16_t)(vv.x & 0xffffu); VT[(seg * 8 + 1) * VS + key] = (bf16_t)(vv.x >> 16);
            VT[(seg * 8 + 2) * VS + key] = (bf16_t)(vv.y & 0xffffu); VT[(seg * 8 + 3) * VS + key] = (bf16_t)(vv.y >> 16);
            VT[(seg * 8 + 4) * VS + key] = (bf16_t)(vv.z & 0xffffu); VT[(seg * 8 + 5) * VS + key] = (bf16_t)(vv.z >> 16);
            VT[(seg * 8 + 6) * VS + key] = (bf16_t)(vv.w & 0xffffu); VT[(seg * 8 + 7) * VS + key] = (bf16_t)(vv.w >> 16); }
        __syncthreads();
#pragma unroll 1
        for (int kt = 0; kt < 4; ++kt) {
            f32x16 sc;
#pragma unroll
            for (int r = 0; r < 16; ++r) sc[r] = 0.f;
#pragma unroll
            for (int s = 0; s < 4; ++s) { const bf16x8 kf = *(const LAS bf16x8*)(KL + (kt * 32 + (lane & 31)) * KS + 16 * s + 8 * hh); sc = __builtin_amdgcn_mfma_f32_32x32x16_bf16(kf, qf[s], sc, 0, 0, 0); }
            if (mask) {
#pragma unroll
                for (int r = 0; r < 16; ++r) { const int kj = kt * 32 + (r & 3) + 8 * (r >> 2) + 4 * hh; const bool ok = mask == 1 ? (kj >= qi) : (kj <= qi); if (!ok) sc[r] = -INFINITY; }
            }
            float mx = sc[0];
#pragma unroll
            for (int r = 1; r < 16; ++r) mx = fmaxf(mx, sc[r]);
            mx = fmaxf(mx, __shfl_xor(mx, 32));
            const float mnew = fmaxf(mrun, mx); const float alpha = exp2f(mrun - mnew); mrun = mnew;
            float ps = 0.f; float p[16];
#pragma unroll
            for (int r = 0; r < 16; ++r) { p[r] = exp2f(sc[r] - mnew); ps += p[r]; }
            lrun = lrun * alpha + ps;
#pragma unroll
            for (int r = 0; r < 16; ++r) { o0[r] *= alpha; o1[r] *= alpha; }
#pragma unroll
            for (int s2 = 0; s2 < 2; ++s2) {
                bf16x8 pf; { u32x4 w; w.x = pk2(p[8 * s2 + 0], p[8 * s2 + 1]); w.y = pk2(p[8 * s2 + 2], p[8 * s2 + 3]); w.z = pk2(p[8 * s2 + 4], p[8 * s2 + 5]); w.w = pk2(p[8 * s2 + 6], p[8 * s2 + 7]); pf = __builtin_bit_cast(bf16x8, w); }
                const int kbase = kt * 32 + 16 * s2 + 4 * hh;
#pragma unroll
                for (int dh = 0; dh < 2; ++dh) {
                    const LAS bf16_t* vp = VT + (dh * 32 + (lane & 31)) * VS + kbase;
                    const u32x2 lo = *(const LAS u32x2*)vp, hi = *(const LAS u32x2*)(vp + 8);
                    u32x4 w; w.x = lo.x; w.y = lo.y; w.z = hi.x; w.w = hi.y; const bf16x8 vf = __builtin_bit_cast(bf16x8, w);
                    if (dh == 0) o0 = __builtin_amdgcn_mfma_f32_32x32x16_bf16(vf, pf, o0, 0, 0, 0); else o1 = __builtin_amdgcn_mfma_f32_32x32x16_bf16(vf, pf, o1, 0, 0, 0);
                }
            }
        }
    }
    const float ltot = lrun + __shfl_xor(lrun, 32); const float inv = 1.0f / ltot;
    bf16_t* orow = YA + (size_t)qrow * BW + head * 64;
#pragma unroll
    for (int g4 = 0; g4 < 4; ++g4) {
        const f32x4 v0 = (f32x4){o0[4 * g4], o0[4 * g4 + 1], o0[4 * g4 + 2], o0[4 * g4 + 3]} * inv, v1 = (f32x4){o1[4 * g4], o1[4 * g4 + 1], o1[4 * g4 + 2], o1[4 * g4 + 3]} * inv;
        *(u32x2*)(orow + 8 * g4 + 4 * hh) = f32_to_bf4(v0); *(u32x2*)(orow + 32 + 8 * g4 + 4 * hh) = f32_to_bf4(v1);
    }
    __syncthreads();
}

__device__ __forceinline__ void sgu_unit(const Args& a, int l, int u, LAS unsigned char* lds, int tid, int lane, int wave) {
    unsigned char* ws = a.ws;
    const bf16_t* GU = (const bf16_t*)(ws + WS_GU); const bf16_t* GV = (const bf16_t*)(ws + WS_GV); bf16_t* YB = (bf16_t*)(ws + WS_Y) + (size_t)TT * BW;
    constexpr int VS = 136;
    LAS bf16_t* VT = (LAS bf16_t*)lds;
    const int chunk = u >> 2, g = u & 3; const int r0 = chunk * 128;
    const float* lng = a.in[I_SLNG] + l * BW; const float* lnb = a.in[I_SLNB] + l * BW;
    __syncthreads();
    for (int t = 0; t < 16; ++t) {
        const int q = wave * 16 + t; const int row = r0 + q;
        const u32x4 raw = *(const u32x4*)(GV + (size_t)row * BW + lane * 8);
        float v[8] = {bflo(raw.x), bfhi(raw.x), bflo(raw.y), bfhi(raw.y), bflo(raw.z), bfhi(raw.z), bflo(raw.w), bfhi(raw.w)};
        float s = 0.f;
#pragma unroll
        for (int i = 0; i < 8; ++i) s += v[i];
        const float mu = wave_sum(s) * (1.0f / BW); float q2 = 0.f;
#pragma unroll
        for (int i = 0; i < 8; ++i) { v[i] -= mu; q2 += v[i] * v[i]; }
        const float rstd = 1.0f / sqrtf(wave_sum(q2) * (1.0f / BW) + 1e-5f);
        if ((lane >> 4) == g) { const int c0 = lane * 8; const int cl = (lane & 15) * 8;
#pragma unroll
            for (int i = 0; i < 8; ++i) { const float vn = v[i] * rstd * lng[c0 + i] + lnb[c0 + i]; VT[(cl + i) * VS + q] = (bf16_t)f2bf(vn); } }
    }
    __syncthreads();
    const float* Wsg = a.in[I_SGUW] + ((size_t)l * 4 + g) * 128 * 128;
    const int fr = lane & 15, fq = lane >> 4; const int pl = wave * 16 + fr;
    bf16x8 wf[4];
#pragma unroll
    for (int ks = 0; ks < 4; ++ks) { const f32x4 w0 = *(const f32x4*)(Wsg + (size_t)pl * 128 + 32 * ks + 8 * fq), w1 = *(const f32x4*)(Wsg + (size_t)pl * 128 + 32 * ks + 8 * fq + 4);
        u32x4 w; w.x = pk2(w0[0], w0[1]); w.y = pk2(w0[2], w0[3]); w.z = pk2(w1[0], w1[1]); w.w = pk2(w1[2], w1[3]); wf[ks] = __builtin_bit_cast(bf16x8, w); }
    const float bias = a.in[I_SGUB][((size_t)l * 4 + g) * 128 + pl];
    const int row = r0 + pl;
#pragma unroll
    for (int cg = 0; cg < 8; ++cg) {
        f32x4 acc = (f32x4){0.f, 0.f, 0.f, 0.f};
#pragma unroll
        for (int ks = 0; ks < 4; ++ks) { const bf16x8 vf = *(const LAS bf16x8*)(VT + (cg * 16 + fr) * VS + 32 * ks + 8 * fq); acc = __builtin_amdgcn_mfma_f32_16x16x32_bf16(vf, wf[ks], acc, 0, 0, 0); }
        const int c = g * 128 + cg * 16 + 4 * fq;
        const f32x4 gu = bf4_to_f32(*(const u32x2*)(GU + (size_t)row * BW + c));
        *(u32x2*)(YB + (size_t)row * BW + c) = f32_to_bf4(gu * (acc + bias));
    }
}

__device__ __forceinline__ bool seq_start(int row) { return row < TL ? ((row & 2047) == 0) : (((row - TL) & 255) == 0); }
__device__ __forceinline__ void conf_unit(const Args& a, int l, int u, LAS unsigned char* lds, int tid, int lane, int wave) {
    unsigned char* ws = a.ws;
    const bf16_t* Z = (const bf16_t*)(ws + WS_Z); bf16_t* YD = (bf16_t*)(ws + WS_Y) + (size_t)3 * TT * BW;
    LAS bf16_t* ZL = (LAS bf16_t*)lds;
    LAS float* OL = (LAS float*)(lds + 63488);
    LAS float* RED = (LAS float*)(lds + 63488 + 65536);
    LAS float* STAT = RED + 512;
    const int r0 = u * 32;
    const int ss = r0 < TL ? (r0 & ~2047) : TL + ((r0 - TL) & ~255); const int se = ss + (r0 < TL ? SEQ : LCTX);
    __syncthreads();
    for (int p = tid; p < 62 * 64; p += NTHR) { const int j = p >> 6, seg = p & 63; const int row = r0 - 15 + j;
        u32x4 v = (u32x4){0u, 0u, 0u, 0u}; if (row >= ss && row < se) v = *(const u32x4*)(Z + (size_t)row * BW + seg * 8);
        *(LAS u32x4*)(ZL + j * 512 + seg * 8) = v; }
    __syncthreads();
    const int c = tid;
    float w[31];
#pragma unroll
    for (int k = 0; k < 31; ++k) w[k] = a.in[I_CDW][((size_t)l * 31 + k) * BW + c];
    const float bias = a.in[I_CDB][l * BW + c];
#pragma unroll 1
    for (int i = 0; i < 32; ++i) {
        float o = bias;
#pragma unroll
        for (int k = 0; k < 31; ++k) o += w[k] * __builtin_bit_cast(float, (unsigned)ZL[(i + k) * 512 + c] << 16);
        OL[i * 512 + c] = o;
        const float s = wave_sum(o), q = wave_sum(o * o);
        if (lane == 0) { RED[wave * 64 + i] = s; RED[wave * 64 + 32 + i] = q; }
    }
    __syncthreads();
    if (tid < 32) { float s = 0.f, q = 0.f;
#pragma unroll
        for (int wv = 0; wv < 8; ++wv) { s += RED[wv * 64 + tid]; q += RED[wv * 64 + 32 + tid]; }
        const float mu = s * (1.0f / BW); const float var = fmaxf(q * (1.0f / BW) - mu * mu, 0.f); STAT[tid] = mu; STAT[32 + tid] = 1.0f / sqrtf(var + 1e-5f); }
    __syncthreads();
    const float lg = a.in[I_CLNG][l * BW + c], lb = a.in[I_CLNB][l * BW + c];
#pragma unroll 4
    for (int i = 0; i < 32; ++i) { const float y = (OL[i * 512 + c] - STAT[i]) * STAT[32 + i] * lg + lb; YD[(size_t)(r0 + i) * BW + c] = (bf16_t)f2bf(siluf_(y)); }
}

__device__ __forceinline__ void sconv_unit(const Args& a, int l, int u, int tid) {
    unsigned char* ws = a.ws;
    const bf16_t* CB = (const bf16_t*)(ws + WS_CB); const bf16_t* CU = (const bf16_t*)(ws + WS_CU); bf16_t* YC = (bf16_t*)(ws + WS_Y) + (size_t)2 * TT * BW;
    const float* W = a.in[I_SCW] + (size_t)l * 3 * BW;
#pragma unroll
    for (int i = 0; i < 4; ++i) { const int p = tid + 512 * i; const int row = u * 32 + (p >> 6), c0 = (p & 63) * 8;
        const bool hasp = !seq_start(row), hasn = (row + 1 < TT) && !seq_start(row + 1);
        const u32x4 z4 = (u32x4){0u, 0u, 0u, 0u};
        const u32x4 um = hasp ? *(const u32x4*)(CU + (size_t)(row - 1) * BW + c0) : z4, u0 = *(const u32x4*)(CU + (size_t)row * BW + c0), up = hasn ? *(const u32x4*)(CU + (size_t)(row + 1) * BW + c0) : z4;
        const u32x4 cb = *(const u32x4*)(CB + (size_t)row * BW + c0);
        const f32x4 wa0 = *(const f32x4*)(W + c0), wa1 = *(const f32x4*)(W + c0 + 4), wb0 = *(const f32x4*)(W + BW + c0), wb1 = *(const f32x4*)(W + BW + c0 + 4), wc0 = *(const f32x4*)(W + 2 * BW + c0), wc1 = *(const f32x4*)(W + 2 * BW + c0 + 4);
        const f32x4 y0 = bf4_to_f32((u32x2){cb.x, cb.y}) * (wa0 * bf4_to_f32((u32x2){um.x, um.y}) + wb0 * bf4_to_f32((u32x2){u0.x, u0.y}) + wc0 * bf4_to_f32((u32x2){up.x, up.y}));
        const f32x4 y1 = bf4_to_f32((u32x2){cb.z, cb.w}) * (wa1 * bf4_to_f32((u32x2){um.z, um.w}) + wb1 * bf4_to_f32((u32x2){u0.z, u0.w}) + wc1 * bf4_to_f32((u32x2){up.z, up.w}));
        const u32x2 a0 = f32_to_bf4(y0), a1 = f32_to_bf4(y1);
        *(u32x4*)(YC + (size_t)row * BW + c0) = (u32x4){a0.x, a0.y, a1.x, a1.y}; }
}

constexpr int N_PHASES = 18;
__global__ void __launch_bounds__(NTHR, 2) fwd_kernel(Args args) {
    extern __shared__ __attribute__((aligned(16))) unsigned char lds_raw[];
    LAS unsigned char* lds = (LAS unsigned char*)lds_raw;
    const int tid0 = threadIdx.x;
    const int G = gridDim.x, wg = blockIdx.x;
    unsigned char* ws = args.ws;
    unsigned* ctl = (unsigned*)(ws + WS_CTL);
    volatile LAS unsigned* MISC = (volatile LAS unsigned*)(lds + MISC_OFF);
    for (int u = tid0; u < (LDS_BYTES - LDSCTL_OFF) / 4; u += NTHR) ((LAS unsigned*)(lds + LDSCTL_OFF))[u] = 0u;
    __syncthreads();
    const int lo = args.ph_lo, hi = args.ph_hi;
    XcdBarrier bar; bar.bar = ctl + CW_BAR; bar.x = 0; bar.st = nullptr;
    if (hi - lo > 1) bar = xcd_barrier_post(ctl + CW_BAR, MISC + 8);
#ifndef PHASE_MASK
#define PHASE_MASK 0x3ff
#endif
#define PM(b) ((PHASE_MASK >> (b)) & 1)
#define IN(k) (lo <= (k) && (k) < hi)
#define FRESH_TID() int tid = threadIdx.x; asm volatile("" : "+v"(tid)); const int lane = tid & 63, wave = __builtin_amdgcn_readfirstlane(tid >> 6);
#define SEAM(k) do { if (IN(k) && IN((k) + 1)) xcd_barrier(bar); } while (0)

    if (PM(0) && IN(0)) { FRESH_TID(); p0_prologue(args, lds, tid, lane, wave, wg, G); }
    SEAM(0);
    for (int l = 0; l < 2; ++l) {
        const int P = 8 * l;
        const int nM = l == 0 ? 36 : 32;
        if (PM(1) && IN(P + 1)) { FRESH_TID(); if (l == 0) norm_phase<0>(args, lane, wave, wg, G); else norm_phase<1>(args, lane, wave, wg, G); }
        SEAM(P + 1);
        if (PM(2) && IN(P + 2)) {
            SchedWin S{(const bf16_t*)(ws + WS_H), (const bf16_t*)(ws + WS_WIN) + (size_t)l * NIN * D, nM, l == 0 ? 0 : 4, G, wg};
            EpiWin E{ws, (const float*)(ws + WS_ROPE)};
            pg8::gemm_phase<EpiWin, SchedWin, false>(lds, D, S, E);
        }
        SEAM(P + 2);
        if (PM(3) && IN(P + 3)) {
            const int nA = l == 0 ? 288 : 256, nS = nM * 8, nC = nM * 8;
            if (DBG_MIX & 1) { FRESH_TID(); for (int u = wg; u < nA; u += G) attn_unit(args, l, u, lds, tid, lane, wave); }
            if (DBG_MIX & 2) { FRESH_TID(); for (int u = (wg + G - 32) % G; u < nS; u += G) sgu_unit(args, l, u, lds, tid, lane, wave); }
            if (DBG_MIX & 4) { FRESH_TID(); for (int u = (wg + G - 64) % G; u < nC; u += G) conf_unit(args, l, u, lds, tid, lane, wave); }
            if (DBG_MIX & 8) { FRESH_TID(); for (int u = (wg + G - 96) % G; u < nC; u += G) sconv_unit(args, l, u, tid); }
        }
        SEAM(P + 3);
        if (PM(4) && IN(P + 4)) {
            SchedBranch S{(const bf16_t*)(ws + WS_Y), (const bf16_t*)(ws + WS_WB) + (size_t)l * 4 * D * BW, nM, G, wg};
            EpiBranch E{(const bf16_t*)(ws + WS_G), (float*)(ws + WS_MS) + (size_t)wg * 65536, (bf16_t*)(ws + WS_MG)};
            pg8::gemm_phase<EpiBranch, SchedBranch, false>(lds, BW, S, E);
        }
        SEAM(P + 4);
        if (PM(5) && IN(P + 5)) {
            SchedOut S{(const bf16_t*)(ws + WS_MG), (const bf16_t*)(ws + WS_WO) + (size_t)l * D * D, nM, G, wg};
            EpiOut E{l == 0 ? args.in[I_X] : (const float*)(ws + WS_XS), l == 0 ? args.in[I_CTX] : (const float*)(ws + WS_XS) + (size_t)TL * D, (float*)(ws + WS_XS), (const float*)(ws + WS_MOD) + (size_t)l * 5 * 12288 + 4096};
            pg8::gemm_phase<EpiOut, SchedOut, false>(lds, D, S, E);
        }
        SEAM(P + 5);
        if (PM(6) && IN(P + 6)) { FRESH_TID(); router_phase(args, l, lds, tid, lane, wave, wg, G); }
        SEAM(P + 6);
        if (PM(7) && IN(P + 7)) {
            { FRESH_TID(); moe_build_list(lds, ctl + CW_CNT + 64 * l, G, wg, tid); }
            SchedMoe<true> S{lds, (const bf16_t*)(ws + WS_H), (const bf16_t*)(ws + WS_WUP) + (size_t)l * NE * D * D, (const int*)(ws + WS_LT)};
            EpiUp E{(bf16_t*)(ws + WS_ACT)};
            pg8::gemm_phase<EpiUp, SchedMoe<true>, true>(lds, D, S, E);
        }
        SEAM(P + 7);
        if (PM(8) && IN(P + 8)) {
            { FRESH_TID(); moe_build_list(lds, ctl + CW_CNT + 64 * l, G, wg, tid); }
            SchedMoe<false> S{lds, (const bf16_t*)(ws + WS_ACT), (const bf16_t*)(ws + WS_WDN) + (size_t)l * NE * D * DFF, (const int*)(ws + WS_LT)};
            EpiDown E{(const int*)(ws + WS_LT), (const float*)(ws + WS_LW), (bf16_t*)(ws + WS_YT)};
            pg8::gemm_phase<EpiDown, SchedMoe<false>, false>(lds, DFF, S, E);
        }
        SEAM(P + 8);
    }
    if (PM(9) && IN(17)) { FRESH_TID(); norm_phase<2>(args, lane, wave, wg, G); }
#undef IN
#undef SEAM
}

extern "C" void kernel_launch(void* const* d_in, const int* in_sizes, int n_in, void* d_out, int out_size, void* d_ws, size_t ws_size, hipStream_t stream) {
    static int grid = 0;
    if (grid == 0) {
        if (n_in != 26 || out_size != TL * D || ws_size < WS_END) { fprintf(stderr, "kernel_launch: unexpected shapes (n_in %d, out %d, ws %zu < %zu)\n", n_in, out_size, ws_size, (size_t)WS_END); grid = -1; return; }
        int dev = 0, cus = 0, per_cu = 0;
        if (hipGetDevice(&dev) != hipSuccess || hipDeviceGetAttribute(&cus, hipDeviceAttributeMultiprocessorCount, dev) != hipSuccess) { grid = -1; return; }
        if (hipFuncSetAttribute((const void*)fwd_kernel, hipFuncAttributeMaxDynamicSharedMemorySize, LDS_BYTES) != hipSuccess) { fprintf(stderr, "kernel_launch: hipFuncSetAttribute failed\n"); grid = -1; return; }
        if (hipOccupancyMaxActiveBlocksPerMultiprocessor(&per_cu, (const void*)fwd_kernel, NTHR, LDS_BYTES) != hipSuccess || per_cu < 1) fprintf(stderr, "kernel_launch: occupancy query reports %d\n", per_cu);
        (void)hipGetLastError();
        grid = cus < 256 ? cus : 256;
    }
    if (grid < 0) return;
    (void)hipMemsetAsync((char*)d_ws + WS_CTL, 0, CTL_BYTES, stream);
    Args a{};
    for (int i = 0; i < 26; ++i) a.in[i] = (const float*)d_in[i];
    a.out = (float*)d_out; a.ws = (unsigned char*)d_ws;
#if MK_N_LAUNCHES == 1
    a.ph_lo = 0; a.ph_hi = N_PHASES;
    hipLaunchKernelGGL(fwd_kernel, dim3(grid), dim3(NTHR), LDS_BYTES, stream, a);
#else
#ifndef DBG_LAST
#define DBG_LAST N_PHASES
#endif
    for (int p = 0; p < DBG_LAST; ++p) { a.ph_lo = p; a.ph_hi = p + 1; hipLaunchKernelGGL(fwd_kernel, dim3(grid), dim3(NTHR), LDS_BYTES, stream, a); }
#endif
}
```

```cpp
#include <hip/hip_runtime.h>
#include <cstdio>
#include <cstdint>

#ifndef DBG_LAST
#define DBG_LAST 18
#endif
#ifndef DBG_MIX
#define DBG_MIX 15
#endif
#ifndef MK_N_LAUNCHES
#define MK_N_LAUNCHES 1
#endif

#define LAS __attribute__((address_space(3)))
#define GAS __attribute__((address_space(1)))
typedef unsigned short bf16_t;
typedef short bf16x8 __attribute__((ext_vector_type(8)));
typedef float f32x4 __attribute__((ext_vector_type(4)));
typedef float f32x2 __attribute__((ext_vector_type(2)));
typedef float f32x16 __attribute__((ext_vector_type(16)));
typedef unsigned u32x4 __attribute__((ext_vector_type(4)));
typedef unsigned u32x2 __attribute__((ext_vector_type(2)));

constexpr int D = 2048, NBATCH = 4, SEQ = 2048, LCTX = 256;
constexpr int TL = NBATCH * SEQ;
constexpr int TC = NBATCH * LCTX;
constexpr int TT = TL + TC;
constexpr int NIN = 12544, NTIN = 49;
constexpr int BW = 512;
constexpr int NE = 16, DFF = 1024;
constexpr int NWAVES = 8, NTHR = 512;
constexpr float LOG2E = 1.4426950408889634f;
constexpr float QSCALE = 0.125f * LOG2E;

constexpr size_t al256(size_t x) { return (x + 255) & ~(size_t)255; }
constexpr size_t WS_CTL = 0, CTL_BYTES = 1u << 20;
constexpr size_t WS_MOD = WS_CTL + CTL_BYTES;
constexpr size_t WS_ROPE = WS_MOD + al256((size_t)2 * 5 * 12288 * 4);
constexpr size_t WS_WIN = WS_ROPE + al256(64 * 32 * 4);
constexpr size_t WS_WB = WS_WIN + (size_t)2 * NIN * D * 2;
constexpr size_t WS_WO = WS_WB + (size_t)2 * 4 * D * BW * 2;
constexpr size_t WS_WUP = WS_WO + (size_t)2 * D * D * 2;
constexpr size_t WS_WDN = WS_WUP + (size_t)32 * D * D * 2;
constexpr size_t WS_XS = WS_WDN + (size_t)32 * D * DFF * 2;
constexpr size_t WS_H = WS_XS + (size_t)TT * D * 4;
constexpr size_t WS_Q = WS_H + (size_t)TT * D * 2;
constexpr size_t WS_K = WS_Q + (size_t)TT * BW * 2;
constexpr size_t WS_V = WS_K + (size_t)TT * 128 * 2;
constexpr size_t WS_GU = WS_V + (size_t)TT * 128 * 2;
constexpr size_t WS_GV = WS_GU + (size_t)TT * BW * 2;
constexpr size_t WS_CB = WS_GV + (size_t)TT * BW * 2;
constexpr size_t WS_CU = WS_CB + (size_t)TT * BW * 2;
constexpr size_t WS_Z = WS_CU + (size_t)TT * BW * 2;
constexpr size_t WS_G = WS_Z + (size_t)TT * BW * 2;
constexpr size_t WS_Y = WS_G + (size_t)TT * 8192 * 2;
constexpr size_t WS_MS = WS_Y + (size_t)4 * TT * BW * 2;
constexpr size_t WS_MG = WS_MS + (size_t)256 * 65536 * 4;
constexpr size_t WS_LT = WS_MG + (size_t)TT * D * 2;
constexpr size_t WS_LW = WS_LT + (size_t)NE * TT * 4;
constexpr int ACT_ROWS = 2 * TT + NE * 256;
constexpr size_t WS_ACT = WS_LW + (size_t)NE * TT * 4;
constexpr size_t WS_YT = WS_ACT + (size_t)ACT_ROWS * DFF * 2;
constexpr size_t WS_END = WS_YT + (size_t)2 * TT * D * 2;
constexpr int CW_CNT = 64;
constexpr int CW_BAR = 4096;

constexpr int RING_BYTES = 131072;
constexpr int LDSCTL_OFF = 135168;
constexpr int MISC_OFF = LDSCTL_OFF + 320;
constexpr int LDS_BYTES = 147456;

__device__ __forceinline__ unsigned f2bf(float f) { unsigned u = __builtin_bit_cast(unsigned, f); return (u + 0x7fffu + ((u >> 16) & 1u)) >> 16; }
__device__ __forceinline__ unsigned pk2(float lo, float hi) { return f2bf(lo) | (f2bf(hi) << 16); }
__device__ __forceinline__ float bflo(unsigned w) { return __builtin_bit_cast(float, w << 16); }
__device__ __forceinline__ float bfhi(unsigned w) { return __builtin_bit_cast(float, w & 0xffff0000u); }
__device__ __forceinline__ f32x4 bf4_to_f32(u32x2 w) { return (f32x4){bflo(w.x), bfhi(w.x), bflo(w.y), bfhi(w.y)}; }
__device__ __forceinline__ u32x2 f32_to_bf4(f32x4 v) { u32x2 w; w.x = pk2(v[0], v[1]); w.y = pk2(v[2], v[3]); return w; }
__device__ __forceinline__ float wave_sum(float v) {
#pragma unroll
    for (int o = 1; o < 64; o <<= 1) v += __shfl_xor(v, o);
    return v;
}
__device__ __forceinline__ float sigmoidf_(float x) { return 1.0f / (1.0f + __expf(-x)); }
__device__ __forceinline__ float siluf_(float x) { return x / (1.0f + __expf(-x)); }
__device__ __forceinline__ float geluf_(float x) { const float z = 0.7978845608028654f * (x + 0.044715f * x * x * x); return x / (1.0f + __expf(-2.0f * z)); }
#define LDS_WAIT() asm volatile("s_waitcnt lgkmcnt(0)" ::: "memory")
#define VM_WAIT() asm volatile("s_waitcnt vmcnt(0)" ::: "memory")

__device__ __forceinline__ int mod_row(int row) { return row < TL ? (row >> 11) : 4; }

namespace pg8 {
constexpr int BM = 256, BK = 64, HALF = 128, HTB = HALF * BK * 2, STAGE_BYTES = 8 * HTB;
__host__ __device__ __forceinline__ int lds_byte(int r, int c) { const int st = (r >> 4) * 2 + (c >> 5), rr = r & 15, cc = c & 31, ob = rr * 64 + cc * 2; return st * 1024 + (ob ^ (((ob >> 9) & 1) << 5)); }
__host__ __device__ __forceinline__ void stage_rc(int b, int& R, int& C) { const int st = b / 1024, sb = b % 1024, swz = sb ^ (((sb >> 9) & 1) << 5); R = (st >> 1) * 16 + swz / 64; C = (st & 1) * 32 + (swz % 64) / 2; }

struct Unit { int pm, pn, z, rb, cnt; };

template <class Epi, class Sched, bool GATHER>
__device__ __forceinline__ void gemm_phase(LAS unsigned char* lds, const int K, const Sched& S, const Epi& E) {
    int tid_l = threadIdx.x; asm volatile("" : "+v"(tid_l));
    const int tid = tid_l, wid = __builtin_amdgcn_readfirstlane(tid >> 6), lane = tid & 63, wr = wid >> 2, wc = wid & 3, fr = lane & 15, fq = lane >> 4;
    const int nt = K / BK;
    unsigned voffA[2], voffB[2]; int sR[2], sC[2];
#pragma unroll
    for (int i = 0; i < 2; ++i) { int R, C; stage_rc(tid * 16 + i * 8192, R, C); sR[i] = R; sC[i] = C; voffA[i] = (unsigned)(R * K + C) * 2u; voffB[i] = voffA[i]; }
    const size_t kstep = (size_t)(BK * 2);
    const size_t hstep = (size_t)HALF * K * 2;
    const unsigned ldsw = (unsigned)wid * 1024u;
    const int aoff = lds_byte(wr * 64 + fr, fq * 8), boff = lds_byte(wc * 32 + fr, fq * 8);
#define PG8_SA(b, h) (((b) * 2 + (h)) * HTB)
#define PG8_SB(b, h) ((4 + (b) * 2 + (h)) * HTB)
#define PG8_STAGE(bufoff, gbase, voff) do { _Pragma("unroll") for (int _i = 0; _i < 2; ++_i) \
        __builtin_amdgcn_global_load_lds((const unsigned*)((const char*)(gbase) + (voff)[_i]), (LAS unsigned*)(lds + (bufoff) + ldsw + _i * 8192), 16, 0, 0); } while (0)
#define PG8_STAGE_A(bufoff, gbase, h, go) do { if constexpr (GATHER) { PG8_STAGE(bufoff, gbase, (go)[h]); } else { PG8_STAGE(bufoff, (gbase) + (h) * hstep, voffA); } } while (0)
#define PG8_LDA(dst, b, h) do { _Pragma("unroll") for (int m = 0; m < 4; ++m) _Pragma("unroll") for (int k = 0; k < 2; ++k) dst[m][k] = *(const LAS bf16x8*)(lds + PG8_SA(b, h) + aoff + m * 2048 + k * 1024); } while (0)
#define PG8_LDB(dst, b, h) do { _Pragma("unroll") for (int n = 0; n < 2; ++n) _Pragma("unroll") for (int k = 0; k < 2; ++k) dst[n][k] = *(const LAS bf16x8*)(lds + PG8_SB(b, h) + boff + n * 2048 + k * 1024); } while (0)
#define PG8_MMA(ai, bj, At, Bt) do { __builtin_amdgcn_s_setprio(1); _Pragma("unroll") for (int m = 0; m < 4; ++m) _Pragma("unroll") for (int n = 0; n < 2; ++n) _Pragma("unroll") for (int k = 0; k < 2; ++k) \
        acc[ai][bj][m][n] = __builtin_amdgcn_mfma_f32_16x16x32_bf16(Bt[n][k], At[m][k], acc[ai][bj][m][n], 0, 0, 0); __builtin_amdgcn_s_setprio(0); } while (0)
#define PG8_WAIT_V(n) asm volatile("s_waitcnt vmcnt(" #n ")" ::: "memory")
#define PG8_WAIT_L(n) asm volatile("s_waitcnt lgkmcnt(" #n ")" ::: "memory")
#define PG8_BAR __builtin_amdgcn_s_barrier()
#define PG8_SCHED __builtin_amdgcn_sched_barrier(0)
    Unit cur, nxt; int ui = 0;
    if (!S.next(0, cur)) return;
    f32x4 acc[2][2][4][2];
#pragma unroll
    for (int a = 0; a < 2; ++a)
#pragma unroll
        for (int b = 0; b < 2; ++b)
#pragma unroll
            for (int m = 0; m < 4; ++m)
#pragma unroll
                for (int n = 0; n < 2; ++n) acc[a][b][m][n] = (f32x4){0.f, 0.f, 0.f, 0.f};
    bf16x8 At[4][2], B0[2][2], B1[2][2];
    unsigned goC[2][2], goN[2][2];
    if constexpr (GATHER) S.a_offs(cur, sR, sC, K, goC); else { goC[0][0] = goC[0][1] = goC[1][0] = goC[1][1] = 0u; }
    const char* cA = S.a_base(cur); const char* cB = S.b_base(cur);
    PG8_STAGE(PG8_SB(0, 0), cB, voffB); PG8_STAGE(PG8_SB(0, 1), cB + hstep, voffB); PG8_STAGE_A(PG8_SA(0, 0), cA, 0, goC); PG8_STAGE_A(PG8_SA(0, 1), cA, 1, goC);
    if (wr == 1) PG8_BAR;
    PG8_WAIT_V(2); PG8_BAR;
    PG8_STAGE(PG8_SB(1, 0), cB + kstep, voffB); PG8_STAGE_A(PG8_SA(1, 0), cA + kstep, 0, goC); PG8_STAGE(PG8_SB(1, 1), cB + hstep + kstep, voffB);
    PG8_WAIT_V(6); PG8_BAR;
    for (;;) {
        const bool has_next = S.next(ui + 1, nxt);
        const char* nA = has_next ? S.a_base(nxt) : cA; const char* nB = has_next ? S.b_base(nxt) : cB;
        if constexpr (GATHER) { if (has_next) S.a_offs(nxt, sR, sC, K, goN); else { goN[0][0] = goC[0][0]; goN[0][1] = goC[0][1]; goN[1][0] = goC[1][0]; goN[1][1] = goC[1][1]; } }
        for (int t = 0; t < nt; t += 2) {
            const bool last = (t == nt - 2);
            const char* a1 = cA + (size_t)(t + 1) * kstep;
            const char* a2 = last ? nA : cA + (size_t)(t + 2) * kstep; const char* b2 = last ? nB : cB + (size_t)(t + 2) * kstep;
            const char* a3 = a2 + kstep; const char* b3 = b2 + kstep;
            unsigned goL[2][2];
            if constexpr (GATHER) { goL[0][0] = last ? goN[0][0] : goC[0][0]; goL[0][1] = last ? goN[0][1] : goC[0][1]; goL[1][0] = last ? goN[1][0] : goC[1][0]; goL[1][1] = last ? goN[1][1] : goC[1][1]; }
            PG8_LDB(B0, 0, 0); PG8_LDB(B1, 0, 1); PG8_SCHED; PG8_LDA(At, 0, 0); PG8_STAGE_A(PG8_SA(1, 1), a1, 1, goC);
            PG8_WAIT_V(8); PG8_WAIT_L(0); PG8_BAR; PG8_MMA(0, 0, At, B0); PG8_MMA(0, 1, At, B1); PG8_BAR; PG8_SCHED;
            PG8_LDA(At, 0, 1); PG8_STAGE(PG8_SB(0, 0), b2, voffB); PG8_STAGE(PG8_SB(0, 1), b2 + hstep, voffB); PG8_STAGE_A(PG8_SA(0, 0), a2, 0, goL);
            PG8_WAIT_V(8); PG8_WAIT_L(0); PG8_BAR; PG8_MMA(1, 0, At, B0); PG8_MMA(1, 1, At, B1); PG8_BAR; PG8_SCHED;
            PG8_LDB(B0, 1, 0); PG8_LDB(B1, 1, 1); PG8_SCHED; PG8_LDA(At, 1, 0); PG8_STAGE_A(PG8_SA(0, 1), a2, 1, goL);
            PG8_WAIT_V(8); PG8_WAIT_L(0); PG8_BAR; PG8_MMA(0, 0, At, B0); PG8_MMA(0, 1, At, B1); PG8_BAR; PG8_SCHED;
            PG8_LDA(At, 1, 1); PG8_STAGE(PG8_SB(1, 0), b3, voffB); PG8_STAGE(PG8_SB(1, 1), b3 + hstep, voffB); PG8_STAGE_A(PG8_SA(1, 0), a3, 0, goL);
            PG8_WAIT_V(8); PG8_WAIT_L(0); PG8_BAR; PG8_MMA(1, 0, At, B0); PG8_MMA(1, 1, At, B1); PG8_BAR; PG8_SCHED;
        }
        if (wr == 0) PG8_BAR;
        E(acc, cur, wr, wc, fr, fq);
        if (!has_next) break;
#pragma unroll
        for (int a = 0; a < 2; ++a)
#pragma unroll
            for (int b = 0; b < 2; ++b)
#pragma unroll
                for (int m = 0; m < 4; ++m)
#pragma unroll
                    for (int n = 0; n < 2; ++n) acc[a][b][m][n] = (f32x4){0.f, 0.f, 0.f, 0.f};
        cur = nxt; cA = nA; cB = nB; ++ui;
        if constexpr (GATHER) { goC[0][0] = goN[0][0]; goC[0][1] = goN[0][1]; goC[1][0] = goN[1][0]; goC[1][1] = goN[1][1]; }
        if (wr == 1) PG8_BAR;
    }
    PG8_WAIT_V(0);
    PG8_BAR;
#undef PG8_SA
#undef PG8_SB
#undef PG8_STAGE
#undef PG8_STAGE_A
#undef PG8_LDA
#undef PG8_LDB
#undef PG8_MMA
#undef PG8_WAIT_V
#undef PG8_WAIT_L
#undef PG8_BAR
#undef PG8_SCHED
}
}
using pg8::Unit;

__device__ __forceinline__ int xcd_remap(int L, int n) { const int q = n / 8, r = n % 8, x = L % 8, off = L / 8; return (x < r ? x * (q + 1) : r * (q + 1) + (x - r) * q) + off; }

struct SchedWin {
    const bf16_t* A; const bf16_t* Bt; int nM, extra, G, c;
    __device__ __forceinline__ bool next(int i, Unit& u) const {
        const int nmain = nM * NTIN, total = nmain + extra; const int L = i * G + c; if (L >= total) return false;
        const int id = xcd_remap(L, total); u.z = 0; u.rb = 0; u.cnt = 0;
        if (id < nmain) { const int nig = 8 * NTIN, gid = id / nig, fm = gid * 8, gsz = (nM - fm) < 8 ? (nM - fm) : 8; u.pm = fm + ((id % nig) % gsz); u.pn = (id % nig) / gsz; }
        else { u.pm = 32 + (id - nmain); u.pn = 2; }
        return true;
    }
    __device__ __forceinline__ const char* a_base(const Unit& u) const { return (const char*)A + (size_t)u.pm * 256 * D * 2; }
    __device__ __forceinline__ const char* b_base(const Unit& u) const { return (const char*)Bt + (size_t)u.pn * 256 * D * 2; }
    __device__ __forceinline__ void a_offs(const Unit&, const int (&)[2], const int (&)[2], int, unsigned (&)[2][2]) const {}
};
struct SchedBranch {
    const bf16_t* Y; const bf16_t* Wb; int nM, G, c;
    __device__ __forceinline__ bool next(int i, Unit& u) const {
        const int ng = nM * 8; const int L = (i >> 2) * G + c; if (L >= ng) return false;
        const int id = xcd_remap(L, ng); u.pm = id >> 3; u.pn = id & 7; u.z = i & 3; u.rb = 0; u.cnt = 0; return true;
    }
    __device__ __forceinline__ const char* a_base(const Unit& u) const { return (const char*)Y + ((size_t)u.z * TT + (size_t)u.pm * 256) * BW * 2; }
    __device__ __forceinline__ const char* b_base(const Unit& u) const { return (const char*)Wb + ((size_t)u.z * D + (size_t)u.pn * 256) * BW * 2; }
    __device__ __forceinline__ void a_offs(const Unit&, const int (&)[2], const int (&)[2], int, unsigned (&)[2][2]) const {}
};
struct SchedOut {
    const bf16_t* A; const bf16_t* Bt; int nM, G, c;
    __device__ __forceinline__ bool next(int i, Unit& u) const {
        const int nu = nM * 8; const int L = i * G + c; if (L >= nu) return false;
        const int id = xcd_remap(L, nu); u.pm = id >> 3; u.pn = id & 7; u.z = 0; u.rb = 0; u.cnt = 0; return true;
    }
    __device__ __forceinline__ const char* a_base(const Unit& u) const { return (const char*)A + (size_t)u.pm * 256 * D * 2; }
    __device__ __forceinline__ const char* b_base(const Unit& u) const { return (const char*)Bt + (size_t)u.pn * 256 * D * 2; }
    __device__ __forceinline__ void a_offs(const Unit&, const int (&)[2], const int (&)[2], int, unsigned (&)[2][2]) const {}
};
constexpr int ULIST_OFF = LDSCTL_OFF + 1024;
__device__ __forceinline__ void moe_build_list(LAS unsigned char* lds, const unsigned* cw, int G, int c, int tid) {
    if (tid < 8) {
        int cnt[NE]; int tp = 0;
#pragma unroll
        for (int e = 0; e < NE; ++e) { cnt[e] = (int)__hip_atomic_load(cw + e, __ATOMIC_RELAXED, __HIP_MEMORY_SCOPE_AGENT); tp += (cnt[e] + 255) >> 8; }
        const int total = tp * 8; const int L = tid * G + c;
        int pm = -1, pn = 0, z = 0, rb = 0, cn = 0;
        if (L < total) {
            const int id = xcd_remap(L, total); int acc = 0;
#pragma unroll
            for (int e = 0; e < NE; ++e) { const int p = (cnt[e] + 255) >> 8; if (id >= acc * 8 && id < (acc + p) * 8) { const int r = id - acc * 8; pn = r / p; pm = r % p; z = e; rb = acc * 256; cn = cnt[e]; } acc += p; }
        }
        LAS int* ul = (LAS int*)(lds + ULIST_OFF) + tid * 8;
        ul[0] = pm; ul[1] = pn; ul[2] = z; ul[3] = rb; ul[4] = cn;
    }
    __syncthreads();
}
template <bool UP>
struct SchedMoe {
    LAS unsigned char* lds; const bf16_t* A; const bf16_t* W; const int* LT;
    __device__ __forceinline__ bool next(int i, Unit& u) const {
        if (i >= 8) return false;
        const LAS int* ul = (const LAS int*)(lds + ULIST_OFF) + i * 8;
        const int pm = __builtin_amdgcn_readfirstlane(ul[0]); if (pm < 0) return false;
        u.pm = pm; u.pn = __builtin_amdgcn_readfirstlane(ul[1]); u.z = __builtin_amdgcn_readfirstlane(ul[2]); u.rb = __builtin_amdgcn_readfirstlane(ul[3]); u.cnt = __builtin_amdgcn_readfirstlane(ul[4]); return true;
    }
    __device__ __forceinline__ const char* a_base(const Unit& u) const { return UP ? (const char*)A : (const char*)A + ((size_t)u.rb + (size_t)u.pm * 256) * DFF * 2; }
    __device__ __forceinline__ const char* b_base(const Unit& u) const { return UP ? (const char*)W + ((size_t)u.z * D + (size_t)u.pn * 256) * D * 2 : (const char*)W + ((size_t)u.z * D + (size_t)u.pn * 256) * DFF * 2; }
    __device__ __forceinline__ void a_offs(const Unit& u, const int (&R)[2], const int (&C)[2], int K, unsigned (&o)[2][2]) const {
#pragma unroll
        for (int h = 0; h < 2; ++h)
#pragma unroll
            for (int i = 0; i < 2; ++i) { const int slot = u.pm * 256 + h * 128 + R[i]; int tok = 0; if (slot < u.cnt) tok = LT[(size_t)u.z * TT + slot] >> 1; o[h][i] = (unsigned)(tok * K + C[i]) * 2u; }
    }
};

struct EpiWin {
    unsigned char* ws; const float* rope;
    __device__ __forceinline__ void operator()(const f32x4 (&acc)[2][2][4][2], const Unit& u, int wr, int wc, int fr, int fq) const {
        const int row0 = u.pm * 256 + wr * 64 + fr; const int pn = u.pn; const int cw = wc * 32 + 4 * fq;
        if (pn <= 2) {
            const bool latent = u.pm < 32; const int half = wc & 1;
            bf16_t* Q = (bf16_t*)(ws + WS_Q); bf16_t* KV = (bf16_t*)(ws + WS_K);
#pragma unroll
            for (int ai = 0; ai < 2; ++ai)
#pragma unroll
                for (int m = 0; m < 4; ++m) {
                    const int row = row0 + ai * 128 + m * 16;
                    f32x4 cs = (f32x4){1.f, 1.f, 1.f, 1.f}, sn = (f32x4){0.f, 0.f, 0.f, 0.f};
                    if (latent) { const int t = row & 2047; const int p = half ? (t & 63) : (t >> 6); cs = *(const f32x4*)(rope + p * 32 + 4 * fq); sn = *(const f32x4*)(rope + p * 32 + 16 + 4 * fq); }
#pragma unroll
                    for (int bj = 0; bj < 2; ++bj) {
                        const f32x4 x1 = acc[ai][bj][m][0], x2 = acc[ai][bj][m][1];
                        if (pn < 2) {
                            const f32x4 o1 = (x1 * cs - x2 * sn) * QSCALE, o2 = (x2 * cs + x1 * sn) * QSCALE;
                            bf16_t* p = Q + (size_t)row * BW + pn * 256 + bj * 128 + cw;
                            *(u32x2*)p = f32_to_bf4(o1); *(u32x2*)(p + 16) = f32_to_bf4(o2);
                        } else if (bj == 0) {
                            const f32x4 o1 = x1 * cs - x2 * sn, o2 = x2 * cs + x1 * sn;
                            bf16_t* p = KV + (size_t)row * 128 + cw;
                            *(u32x2*)p = f32_to_bf4(o1); *(u32x2*)(p + 16) = f32_to_bf4(o2);
                        } else {
                            bf16_t* p = KV + (size_t)TT * 128 + (size_t)row * 128 + cw;
                            *(u32x2*)p = f32_to_bf4(x1); *(u32x2*)(p + 16) = f32_to_bf4(x2);
                        }
                    }
                    asm volatile("" ::: "memory");
                }
        } else if (pn <= 8) {
            bf16_t* O = (bf16_t*)(ws + WS_GU) + (size_t)((pn - 3) >> 1) * TT * BW; const int ct = ((pn - 3) & 1) * 256; const bool act = pn <= 6;
#pragma unroll
            for (int ai = 0; ai < 2; ++ai)
#pragma unroll
                for (int m = 0; m < 4; ++m) { const int row = row0 + ai * 128 + m * 16;
#pragma unroll
                    for (int bj = 0; bj < 2; ++bj)
#pragma unroll
                        for (int n = 0; n < 2; ++n) { f32x4 v = acc[ai][bj][m][n];
                            if (act) { v[0] = geluf_(v[0]); v[1] = geluf_(v[1]); v[2] = geluf_(v[2]); v[3] = geluf_(v[3]); }
                            *(u32x2*)(O + (size_t)row * BW + ct + bj * 128 + cw + 16 * n) = f32_to_bf4(v); }
                    asm volatile("" ::: "memory"); }
        } else if (pn <= 16) {
            const bool glu = pn >= 13; bf16_t* O = (bf16_t*)(ws + WS_CU) + (glu ? (size_t)TT * BW : (size_t)0); const int ct = ((pn - 9) & 3) * 128;
#pragma unroll
            for (int ai = 0; ai < 2; ++ai)
#pragma unroll
                for (int m = 0; m < 4; ++m) { const int row = row0 + ai * 128 + m * 16;
#pragma unroll
                    for (int n = 0; n < 2; ++n) { const f32x4 a = acc[ai][0][m][n], b = acc[ai][1][m][n]; f32x4 v;
                        if (glu) { v[0] = a[0] * sigmoidf_(b[0]); v[1] = a[1] * sigmoidf_(b[1]); v[2] = a[2] * sigmoidf_(b[2]); v[3] = a[3] * sigmoidf_(b[3]); } else v = a * b;
                        *(u32x2*)(O + (size_t)row * BW + ct + cw + 16 * n) = f32_to_bf4(v); }
                    asm volatile("" ::: "memory"); }
        } else {
            bf16_t* G = (bf16_t*)(ws + WS_G); const int ct = (pn - 17) * 256;
#pragma unroll
            for (int ai = 0; ai < 2; ++ai)
#pragma unroll
                for (int m = 0; m < 4; ++m) { const int row = row0 + ai * 128 + m * 16;
#pragma unroll
                    for (int bj = 0; bj < 2; ++bj)
#pragma unroll
                        for (int n = 0; n < 2; ++n) { f32x4 v = acc[ai][bj][m][n]; v[0] = sigmoidf_(v[0]); v[1] = sigmoidf_(v[1]); v[2] = sigmoidf_(v[2]); v[3] = sigmoidf_(v[3]);
                            *(u32x2*)(G + (size_t)row * 8192 + ct + bj * 128 + cw + 16 * n) = f32_to_bf4(v); }
                    asm volatile("" ::: "memory"); }
        }
    }
};
struct EpiBranch {
    const bf16_t* G; float* MS; bf16_t* MG;
    __device__ __forceinline__ void operator()(const f32x4 (&acc)[2][2][4][2], const Unit& u, int wr, int wc, int fr, int fq) const {
        const int row0 = u.pm * 256 + wr * 64 + fr; const int cw = wc * 32 + 4 * fq; const int z = u.z;
        f32x4* ms = (f32x4*)MS + threadIdx.x; asm volatile("" : "+v"(ms));
#pragma unroll
        for (int ai = 0; ai < 2; ++ai)
#pragma unroll
            for (int m = 0; m < 4; ++m) { const int row = row0 + ai * 128 + m * 16;
#pragma unroll
                for (int bj = 0; bj < 2; ++bj)
#pragma unroll
                    for (int n = 0; n < 2; ++n) {
                        const int col = u.pn * 256 + bj * 128 + cw + 16 * n; const int slot = ((ai * 4 + m) * 2 + bj) * 2 + n;
                        const f32x4 g = bf4_to_f32(*(const u32x2*)(G + (size_t)row * 8192 + z * 2048 + col));
                        f32x4 v = acc[ai][bj][m][n] * g;
                        if (z > 0) v += ms[slot * 512];
                        if (z < 3) ms[slot * 512] = v; else *(u32x2*)(MG + (size_t)row * D + col) = f32_to_bf4(v);
                    }
                asm volatile("" ::: "memory"); }
    }
};
struct EpiOut {
    const float* srcL; const float* srcC; float* XS; const float* g1;
    __device__ __forceinline__ void operator()(const f32x4 (&acc)[2][2][4][2], const Unit& u, int wr, int wc, int fr, int fq) const {
        const int row0 = u.pm * 256 + wr * 64 + fr; const int cw = wc * 32 + 4 * fq;
        const int mr = u.pm < 32 ? (u.pm >> 3) : 4; const float* gp = g1 + (size_t)mr * 12288;
        const float* src = u.pm < 32 ? srcL : srcC - (size_t)TL * D;
        f32x4 gv[2][2];
#pragma unroll
        for (int bj = 0; bj < 2; ++bj)
#pragma unroll
            for (int n = 0; n < 2; ++n) gv[bj][n] = *(const f32x4*)(gp + u.pn * 256 + bj * 128 + cw + 16 * n);
#pragma unroll
        for (int ai = 0; ai < 2; ++ai)
#pragma unroll
            for (int m = 0; m < 4; ++m) { const size_t off = (size_t)(row0 + ai * 128 + m * 16) * D + u.pn * 256 + cw;
#pragma unroll
                for (int bj = 0; bj < 2; ++bj)
#pragma unroll
                    for (int n = 0; n < 2; ++n) { const f32x4 s = *(const f32x4*)(src + off + bj * 128 + 16 * n); *(f32x4*)(XS + off + bj * 128 + 16 * n) = s + gv[bj][n] * acc[ai][bj][m][n]; }
                asm volatile("" ::: "memory"); }
    }
};
struct EpiUp {
    bf16_t* ACT;
    __device__ __forceinline__ void operator()(const f32x4 (&acc)[2][2][4][2], const Unit& u, int wr, int wc, int fr, int fq) const {
        const int row0 = u.rb + u.pm * 256 + wr * 64 + fr; const int cw = wc * 32 + 4 * fq;
#pragma unroll
        for (int ai = 0; ai < 2; ++ai)
#pragma unroll
            for (int m = 0; m < 4; ++m) { const int row = row0 + ai * 128 + m * 16;
#pragma unroll
                for (int n = 0; n < 2; ++n) { const f32x4 a = acc[ai][0][m][n], b = acc[ai][1][m][n]; f32x4 v;
                    v[0] = siluf_(a[0]) * b[0]; v[1] = siluf_(a[1]) * b[1]; v[2] = siluf_(a[2]) * b[2]; v[3] = siluf_(a[3]) * b[3];
                    *(u32x2*)(ACT + (size_t)row * DFF + u.pn * 128 + cw + 16 * n) = f32_to_bf4(v); } }
    }
};
struct EpiDown {
    const int* LT; const float* LW; bf16_t* YT;
    __device__ __forceinline__ void operator()(const f32x4 (&acc)[2][2][4][2], const Unit& u, int wr, int wc, int fr, int fq) const {
        const int s0 = u.pm * 256 + wr * 64 + fr; const int cw = wc * 32 + 4 * fq;
#pragma unroll
        for (int ai = 0; ai < 2; ++ai)
#pragma unroll
            for (int m = 0; m < 4; ++m) { const int slot = s0 + ai * 128 + m * 16;
                if (slot < u.cnt) { const int tj = LT[(size_t)u.z * TT + slot]; const float w = LW[(size_t)u.z * TT + slot];
#pragma unroll
                    for (int bj = 0; bj < 2; ++bj)
#pragma unroll
                        for (int n = 0; n < 2; ++n) *(u32x2*)(YT + (size_t)tj * D + u.pn * 256 + bj * 128 + cw + 16 * n) = f32_to_bf4(acc[ai][bj][m][n] * w); } }
    }
};

#define XB_TMO      128
#define XB_XCNT(j)  (256  + 64 * (j))
#define XB_XSUB(j)  (1280 + 64 * (j))
#define XB_XGEN(j)  (2304 + 64 * (j))
#define XB_TOP      3328
#define XB_TOPGEN   3392
#define XCD_BAR_WORDS 3456
#define XB_SPIN_CAP (1u << 22)
__device__ __forceinline__ unsigned xb_ld(unsigned* p)              { return __hip_atomic_load(p, __ATOMIC_RELAXED, __HIP_MEMORY_SCOPE_AGENT); }
__device__ __forceinline__ unsigned xb_add(unsigned* p, unsigned v) { return __hip_atomic_fetch_add(p, v, __ATOMIC_RELAXED, __HIP_MEMORY_SCOPE_AGENT); }
__device__ __forceinline__ unsigned xb_xcc_id() { return (unsigned)__builtin_amdgcn_s_getreg((3 << 11) | 20) & 0xFu; }
#define XB_SPIN(cond, bar) do { unsigned _sp = 0; while (cond) { __builtin_amdgcn_s_sleep(1); \
    if ((++_sp & 255u) == 0u) { if (xb_ld(&(bar)[XB_TMO])) break; if (_sp > XB_SPIN_CAP) { atomicAdd(&(bar)[XB_TMO], 1u); break; } } } } while (0)
struct XcdBarrier { unsigned* bar; unsigned x; volatile LAS unsigned* st; };
__device__ __forceinline__ XcdBarrier xcd_barrier_post(unsigned* bar, volatile LAS unsigned* st) {
    XcdBarrier b; b.bar = bar; b.x = xb_xcc_id(); b.st = st;
    if (threadIdx.x == 0) (void)xb_add(&bar[XB_XCNT(b.x)], 1u);
    return b;
}
__device__ __forceinline__ void xcd_barrier_complete(unsigned* bar, unsigned x, unsigned& nloc, unsigned& nx) {
    const unsigned G = gridDim.x * gridDim.y * gridDim.z;
    unsigned sum, cnt, mine, sp = 0u;
    for (;;) {
        sum = 0u; cnt = 0u; mine = 0u;
#pragma unroll
        for (unsigned j = 0; j < 16; ++j) { const unsigned c = xb_ld(&bar[XB_XCNT(j)]); sum += c; cnt += (c > 0u) ? 1u : 0u; mine = (j == x) ? c : mine; }
        if (sum == G) break;
        __builtin_amdgcn_s_sleep(1);
        if ((++sp & 255u) == 0u) { if (xb_ld(&bar[XB_TMO])) break; if (sp > XB_SPIN_CAP) { atomicAdd(&bar[XB_TMO], 1u); break; } }
    }
    nloc = mine > 0u ? mine : 1u; nx = cnt > 0u ? cnt : 1u;
}
__device__ __forceinline__ void xcd_barrier(const XcdBarrier& b) {
    asm volatile("s_waitcnt vmcnt(0)" ::: "memory");
    __syncthreads();
    if (threadIdx.x == 0) {
        unsigned* bar = b.bar;
        __builtin_amdgcn_s_waitcnt(0);
        unsigned nloc = b.st[0], nx = b.st[1];
        if (nloc == 0u) { xcd_barrier_complete(bar, b.x, nloc, nx); b.st[0] = nloc; b.st[1] = nx; }
        const unsigned old = xb_add(&bar[XB_XSUB(b.x)], 1u);
        const unsigned gen = old / nloc;
        if (old + 1u == (gen + 1u) * nloc) {
            __builtin_amdgcn_fence(__ATOMIC_RELEASE, "agent");
            asm volatile("s_waitcnt vmcnt(0)" ::: "memory");
            const unsigned og = xb_add(&bar[XB_TOP], 1u);
            const unsigned tg = og / nx;
            if (og + 1u == (tg + 1u) * nx) xb_add(&bar[XB_TOPGEN], 1u);
            else XB_SPIN(xb_ld(&bar[XB_TOPGEN]) == tg, bar);
            __builtin_amdgcn_fence(__ATOMIC_ACQUIRE, "agent");
            xb_add(&bar[XB_XGEN(b.x)], 1u);
            asm volatile("s_waitcnt vmcnt(0)" ::: "memory");
        } else {
            XB_SPIN(xb_ld(&bar[XB_XGEN(b.x)]) == gen, bar);
            __builtin_amdgcn_fence(__ATOMIC_ACQUIRE, "agent");
            asm volatile("s_waitcnt vmcnt(0)" ::: "memory");
        }
    }
    __syncthreads();
}

struct Args { const float* in[26]; float* out; unsigned char* ws; int ph_lo, ph_hi; };
enum { I_X = 0, I_C, I_CTX, I_CCTX, I_ADAW, I_ADAB, I_N1G, I_N2G, I_WIN, I_SINK, I_SLNG, I_SLNB, I_SGUW, I_SGUB, I_SCW, I_CDW, I_CDB, I_CLNG, I_CLNB, I_WBR, I_WOUT, I_RW, I_RB, I_WUP, I_WDN, I_FG };

__device__ __forceinline__ void transpose_item(const float* W, int K, int N, bf16_t* WT, int k0, int s0, int n0, LAS float* scr, int lane) {
#pragma unroll 8
    for (int i = 0; i < 32; ++i) { const int kk = 2 * i + (lane >> 5); scr[kk * 33 + (lane & 31)] = W[(size_t)(k0 + kk) * N + s0 + (lane & 31)]; }
    LDS_WAIT(); asm volatile("" ::: "memory");
    const int c = lane & 7;
#pragma unroll
    for (int j = 0; j < 4; ++j) { const int n = (lane >> 3) + 8 * j; const LAS float* s = scr + (8 * c) * 33 + n;
        u32x4 o; o.x = pk2(s[0 * 33], s[1 * 33]); o.y = pk2(s[2 * 33], s[3 * 33]); o.z = pk2(s[4 * 33], s[5 * 33]); o.w = pk2(s[6 * 33], s[7 * 33]);
        *(u32x4*)(WT + (size_t)(n0 + n) * K + k0 + 8 * c) = o; }
    LDS_WAIT(); asm volatile("" ::: "memory");
}
__device__ __forceinline__ int win_src(int n) {
    const int pn = n >> 8, j = n & 255;
    if (pn < 9) return n;
    if (pn < 13) { const int t = pn - 9; return j < 128 ? 2304 + t * 128 + j : 2816 + t * 128 + (j - 128); }
    if (pn < 17) { const int t = pn - 13; return j < 128 ? 3328 + t * 128 + j : 3840 + t * 128 + (j - 128); }
    return n;
}
__device__ __forceinline__ int up_src(int n) { const int pn = n >> 8, j = n & 255; return j < 128 ? pn * 128 + j : 1024 + pn * 128 + (j - 128); }

__device__ __forceinline__ void p0_prologue(const Args& a, LAS unsigned char* lds, int tid, int lane, int wave, int wg, int G) {
    unsigned char* ws = a.ws;
    if (wg == 0) {
        float* rope = (float*)(ws + WS_ROPE);
        for (int idx = tid; idx < 64 * 16; idx += NTHR) { const int p = idx >> 4, j = idx & 15; const float inv = 1.0f / powf(10000.0f, (float)(2 * j) / 32.0f); const float ang = (float)p * inv; float s, c; sincosf(ang, &s, &c); rope[p * 32 + j] = c; rope[p * 32 + 16 + j] = s; }
    }
    {
        LAS float* SC = (LAS float*)lds;
        LAS float* RED = (LAS float*)(lds + 40960);
        for (int idx = tid; idx < 5 * D; idx += NTHR) { const int r = idx >> 11, k = idx & 2047; const float v = r < 4 ? a.in[I_C][r * D + k] : a.in[I_CCTX][k]; SC[idx] = siluf_(v); }
        __syncthreads();
        float* MOD = (float*)(ws + WS_MOD);
        for (int it = wg; it < 768; it += G) {
            const int l = it / 384, ch = it % 384; const int col = ch * 32 + (lane & 31); const int kp = lane >> 5;
            const float* W = a.in[I_ADAW] + (size_t)l * D * 12288 + col;
            float s0 = 0.f, s1 = 0.f, s2 = 0.f, s3 = 0.f, s4 = 0.f;
#pragma unroll 8
            for (int i = 0; i < 128; ++i) { const int k = wave * 256 + 2 * i + kp; const float w = W[(size_t)k * 12288];
                s0 += SC[k] * w; s1 += SC[2048 + k] * w; s2 += SC[4096 + k] * w; s3 += SC[6144 + k] * w; s4 += SC[8192 + k] * w; }
            s0 += __shfl_xor(s0, 32); s1 += __shfl_xor(s1, 32); s2 += __shfl_xor(s2, 32); s3 += __shfl_xor(s3, 32); s4 += __shfl_xor(s4, 32);
            if (lane < 32) { RED[(wave * 5 + 0) * 32 + lane] = s0; RED[(wave * 5 + 1) * 32 + lane] = s1; RED[(wave * 5 + 2) * 32 + lane] = s2; RED[(wave * 5 + 3) * 32 + lane] = s3; RED[(wave * 5 + 4) * 32 + lane] = s4; }
            __syncthreads();
            if (tid < 160) { const int r = tid >> 5, cc = tid & 31; float s = 0.f;
#pragma unroll
                for (int w = 0; w < 8; ++w) s += RED[(w * 5 + r) * 32 + cc];
                MOD[((size_t)l * 5 + r) * 12288 + ch * 32 + cc] = s + a.in[I_ADAB][l * 12288 + ch * 32 + cc]; }
            __syncthreads();
        }
    }
    {
        LAS float* scr = (LAS float*)(lds + wave * 16384);
        const int gw = wg * NWAVES + wave, NGW = G * NWAVES;
        constexpr int I_IN = 2 * 32 * (NIN / 32), I_BR = 8 * 8 * 64, I_OUT = 2 * 32 * 64, I_UP = 32 * 32 * 64, I_DN = 32 * 16 * 64;
        constexpr int NITEMS = I_IN + I_BR + I_OUT + I_UP + I_DN;
        for (int it = gw; it < NITEMS; it += NGW) {
            int r = it;
            if (r < I_IN) { const int per = 32 * (NIN / 32); const int l = r / per; r %= per; const int kb = r / (NIN / 32), nb = r % (NIN / 32);
                transpose_item(a.in[I_WIN] + (size_t)l * D * NIN, D, NIN, (bf16_t*)(ws + WS_WIN) + (size_t)l * NIN * D, kb * 64, win_src(nb * 32), nb * 32, scr, lane); continue; }
            r -= I_IN;
            if (r < I_BR) { const int mz = r / 512; r %= 512; const int kb = r / 64, nb = r % 64;
                transpose_item(a.in[I_WBR] + (size_t)mz * BW * D, BW, D, (bf16_t*)(ws + WS_WB) + (size_t)mz * D * BW, kb * 64, nb * 32, nb * 32, scr, lane); continue; }
            r -= I_BR;
            if (r < I_OUT) { const int l = r / 2048; r %= 2048; const int kb = r / 64, nb = r % 64;
                transpose_item(a.in[I_WOUT] + (size_t)l * D * D, D, D, (bf16_t*)(ws + WS_WO) + (size_t)l * D * D, kb * 64, nb * 32, nb * 32, scr, lane); continue; }
            r -= I_OUT;
            if (r < I_UP) { const int le = r / 2048; r %= 2048; const int kb = r / 64, nb = r % 64;
                transpose_item(a.in[I_WUP] + (size_t)le * D * D, D, D, (bf16_t*)(ws + WS_WUP) + (size_t)le * D * D, kb * 64, up_src(nb * 32), nb * 32, scr, lane); continue; }
            r -= I_UP;
            { const int le = r / 1024; r %= 1024; const int kb = r / 64, nb = r % 64;
                transpose_item(a.in[I_WDN] + (size_t)le * DFF * D, DFF, D, (bf16_t*)(ws + WS_WDN) + (size_t)le * D * DFF, kb * 64, nb * 32, nb * 32, scr, lane); }
        }
    }
}

template <int MODE>
__device__ __forceinline__ void norm_phase(const Args& a, int lane, int wave, int wg, int G) {
    unsigned char* ws = a.ws;
    const float* MOD = (const float*)(ws + WS_MOD);
    float* XS = (float*)(ws + WS_XS); bf16_t* H = (bf16_t*)(ws + WS_H); const bf16_t* YT = (const bf16_t*)(ws + WS_YT);
    const int nrows = MODE == 2 ? TL : TT;
    const int gw = wg * NWAVES + wave, NGW = G * NWAVES;
    for (int row = gw; row < nrows; row += NGW) {
        const int mr = mod_row(row);
        const float* src = MODE == 0 ? (row < TL ? a.in[I_X] + (size_t)row * D : a.in[I_CTX] + (size_t)(row - TL) * D) : XS + (size_t)row * D;
        f32x4 x[8]; float ss = 0.f;
#pragma unroll
        for (int j = 0; j < 8; ++j) x[j] = *(const f32x4*)(src + 256 * j + 4 * lane);
        if (MODE != 0) {
            const float* g2 = MOD + ((size_t)0 * 5 + mr) * 12288 + 10240;
            const float* g2p = MODE == 1 ? g2 : g2 + (size_t)5 * 12288;
#pragma unroll
            for (int j = 0; j < 8; ++j) {
                const f32x4 y0 = bf4_to_f32(*(const u32x2*)(YT + (size_t)(2 * row) * D + 256 * j + 4 * lane)), y1 = bf4_to_f32(*(const u32x2*)(YT + (size_t)(2 * row + 1) * D + 256 * j + 4 * lane));
                const f32x4 g = *(const f32x4*)(g2p + 256 * j + 4 * lane);
                x[j] += g * (y0 + y1);
            }
            if (MODE == 1) {
#pragma unroll
                for (int j = 0; j < 8; ++j) *(f32x4*)(XS + (size_t)row * D + 256 * j + 4 * lane) = x[j];
            }
        }
#pragma unroll
        for (int j = 0; j < 8; ++j) ss += (x[j][0] * x[j][0] + x[j][1] * x[j][1]) + (x[j][2] * x[j][2] + x[j][3] * x[j][3]);
        const float rstd = 1.0f / sqrtf(wave_sum(ss) * (1.0f / D) + 1e-6f);
        if (MODE == 2) {
#pragma unroll
            for (int j = 0; j < 8; ++j) { const f32x4 g = *(const f32x4*)(a.in[I_FG] + 256 * j + 4 * lane); *(f32x4*)(a.out + (size_t)row * D + 256 * j + 4 * lane) = x[j] * rstd * g; }
        } else {
            const int l = MODE;
            const float* m = MOD + ((size_t)l * 5 + mr) * 12288; const float* gn = a.in[I_N1G] + (size_t)l * D;
#pragma unroll
            for (int j = 0; j < 8; ++j) { const int c = 256 * j + 4 * lane; const f32x4 g = *(const f32x4*)(gn + c), sh = *(const f32x4*)(m + c), sc = *(const f32x4*)(m + 2048 + c);
                const f32x4 h = x[j] * rstd * g * (sc + 1.0f) + sh; *(u32x2*)(H + (size_t)row * D + c) = f32_to_bf4(h); }
        }
    }
}

__device__ __forceinline__ void router_phase(const Args& a, int l, LAS unsigned char* lds, int tid, int lane, int wave, int wg, int G) {
    unsigned char* ws = a.ws;
    constexpr int RWS = 2052;
    LAS float* RWT = (LAS float*)lds;
    LAS int* RE = (LAS int*)(lds + 16 * RWS * 4);
    LAS float* RWGT = (LAS float*)(lds + 16 * RWS * 4 + 512);
    LAS int* RBASE = (LAS int*)(lds + 16 * RWS * 4 + 1024);
    const int nrows = l == 0 ? TT : TL; const int rpw = nrows / G;
    for (int idx = tid; idx < D * NE; idx += NTHR) { const int k = idx >> 4, e = idx & 15; RWT[e * RWS + k] = a.in[I_RW][idx]; }
    __syncthreads();
    const float* MOD = (const float*)(ws + WS_MOD) + (size_t)l * 5 * 12288;
    const float* XS = (const float*)(ws + WS_XS); bf16_t* H = (bf16_t*)(ws + WS_H); const float* gn = a.in[I_N2G] + (size_t)l * D;
    for (int rl = wave; rl < rpw; rl += NWAVES) {
        const int row = wg * rpw + rl; const int mr = mod_row(row); const float* m = MOD + (size_t)mr * 12288;
        f32x4 x[8]; float ss = 0.f;
#pragma unroll
        for (int j = 0; j < 8; ++j) { x[j] = *(const f32x4*)(XS + (size_t)row * D + 256 * j + 4 * lane); ss += (x[j][0] * x[j][0] + x[j][1] * x[j][1]) + (x[j][2] * x[j][2] + x[j][3] * x[j][3]); }
        const float rstd = 1.0f / sqrtf(wave_sum(ss) * (1.0f / D) + 1e-6f);
#pragma unroll
        for (int j = 0; j < 8; ++j) { const int c = 256 * j + 4 * lane; const f32x4 g = *(const f32x4*)(gn + c), sh = *(const f32x4*)(m + 6144 + c), sc = *(const f32x4*)(m + 8192 + c);
            x[j] = x[j] * rstd * g * (sc + 1.0f) + sh; *(u32x2*)(H + (size_t)row * D + c) = f32_to_bf4(x[j]); }
        float lg[NE];
#pragma unroll
        for (int e = 0; e < NE; ++e) { float s = 0.f;
#pragma unroll
            for (int j = 0; j < 8; ++j) { const f32x4 w = *(const LAS f32x4*)(RWT + e * RWS + 256 * j + 4 * lane); s += (x[j][0] * w[0] + x[j][1] * w[1]) + (x[j][2] * w[2] + x[j][3] * w[3]); }
            lg[e] = wave_sum(s); }
        float mx = lg[0];
#pragma unroll
        for (int e = 1; e < NE; ++e) mx = fmaxf(mx, lg[e]);
        float sc_[NE], den = 0.f;
#pragma unroll
        for (int e = 0; e < NE; ++e) { sc_[e] = expf(lg[e] - mx); den += sc_[e]; }
        float bi[NE];
#pragma unroll
        for (int e = 0; e < NE; ++e) { sc_[e] = sc_[e] / den; bi[e] = sc_[e] + a.in[I_RB][e]; }
        float bestg = -3.0e38f; int gsel = 0;
#pragma unroll
        for (int g = 0; g < 4; ++g) { float m1 = -3.0e38f, m2 = -3.0e38f;
#pragma unroll
            for (int q = 0; q < 4; ++q) { const float v = bi[g * 4 + q]; if (v > m1) { m2 = m1; m1 = v; } else if (v > m2) m2 = v; }
            const float gs = m1 + m2; if (gs > bestg) { bestg = gs; gsel = g; } }
        float b0 = -3.0e38f, b1 = -3.0e38f, s0 = 0.f, s1 = 0.f; int i0 = 0, i1 = 0;
#pragma unroll
        for (int e = 0; e < NE; ++e) if ((e >> 2) == gsel) { const float v = bi[e];
            if (v > b0) { b1 = b0; i1 = i0; s1 = s0; b0 = v; i0 = e; s0 = sc_[e]; } else if (v > b1) { b1 = v; i1 = e; s1 = sc_[e]; } }
        if (lane == 0) { RE[rl * 2] = i0; RE[rl * 2 + 1] = i1; const float inv = 1.0f / (s0 + s1); RWGT[rl * 2] = s0 * inv; RWGT[rl * 2 + 1] = s1 * inv; }
    }
    __syncthreads();
    unsigned* cw = (unsigned*)(ws + WS_CTL) + CW_CNT + 64 * l;
    if (tid < NE) { int n = 0; for (int i = 0; i < 2 * rpw; ++i) n += (RE[i] == tid) ? 1 : 0; RBASE[tid] = n ? (int)__hip_atomic_fetch_add(cw + tid, (unsigned)n, __ATOMIC_RELAXED, __HIP_MEMORY_SCOPE_AGENT) : 0; }
    __syncthreads();
    if (tid < 2 * rpw) { const int e = RE[tid]; int rank = RBASE[e]; for (int i = 0; i < tid; ++i) rank += (RE[i] == e) ? 1 : 0;
        const int row = wg * rpw + (tid >> 1);
        ((int*)(ws + WS_LT))[(size_t)e * TT + rank] = row * 2 + (tid & 1); ((float*)(ws + WS_LW))[(size_t)e * TT + rank] = RWGT[tid]; }
    __syncthreads();
}

__device__ __forceinline__ void attn_unit(const Args& a, int l, int u, LAS unsigned char* lds, int tid, int lane, int wave) {
    unsigned char* ws = a.ws;
    const bf16_t* Q = (const bf16_t*)(ws + WS_Q); const bf16_t* KB = (const bf16_t*)(ws + WS_K); const bf16_t* VB = (const bf16_t*)(ws + WS_V);
    bf16_t* YA = (bf16_t*)(ws + WS_Y);
    constexpr int KS = 72, VS = 136;
    LAS bf16_t* KL = (LAS bf16_t*)lds;
    LAS bf16_t* VT = (LAS bf16_t*)(lds + 128 * KS * 2);
    int b, g, hp, qrow0, nb = 0; bool isctx;
    if (u < 256) { hp = u & 1; g = (u >> 1) & 1; nb = (u >> 2) & 15; b = u >> 6; qrow0 = b * SEQ + nb * 128; isctx = false; }
    else { const int v = u - 256; hp = v & 1; g = (v >> 1) & 1; const int cb = (v >> 2) & 1; b = v >> 3; qrow0 = TL + b * LCTX + cb * 128; isctx = true; }
    const int head = g * 4 + hp * 2 + (wave >> 2); const int qi = (wave & 3) * 32 + (lane & 31); const int hh = lane >> 5;
    const int qrow = qrow0 + qi;
    bf16x8 qf[4];
#pragma unroll
    for (int s = 0; s < 4; ++s) qf[s] = *(const bf16x8*)(Q + (size_t)qrow * BW + head * 64 + 16 * s + 8 * hh);
    const float sink2 = a.in[I_SINK][l * 8 + head] * LOG2E;
    float mrun = sink2, lrun = (lane < 32) ? 1.0f : 0.0f;
    f32x16 o0, o1;
#pragma unroll
    for (int r = 0; r < 16; ++r) { o0[r] = 0.f; o1[r] = 0.f; }
    for (int ch = 0; ch < 5; ++ch) {
        int krow0, mask = 0;
        if (ch < 3) { if (isctx) continue; const int kb = nb - 1 + ch; if (kb < 0 || kb > 15) continue; krow0 = b * SEQ + kb * 128; mask = ch == 0 ? 1 : (ch == 2 ? 2 : 0); }
        else krow0 = TL + b * LCTX + (ch - 3) * 128;
        __syncthreads();
#pragma unroll
        for (int i = 0; i < 2; ++i) { const int p = tid + 512 * i; const int key = p >> 3, seg = p & 7;
            const u32x4 kv = *(const u32x4*)(KB + (size_t)(krow0 + key) * 128 + g * 64 + seg * 8);
            *(LAS u32x4*)(KL + key * KS + seg * 8) = kv;
            const u32x4 vv = *(const u32x4*)(VB + (size_t)(krow0 + key) * 128 + g * 64 + seg * 8);
            VT[(seg * 8 + 0) * VS + key] = (bf16_t)(vv.x & 0xffffu); VT[(seg * 8 + 1) * VS + key] = (bf16_t)(vv.x >> 16);
            VT[(seg * 8 + 2) * VS + key] = (bf16_t)(vv.y & 0xffffu); VT[(seg * 8 + 3) * VS + key] = (bf16_t)(vv.y >> 16);
            VT[(seg * 8 + 4) * VS + key] = (bf16_t)(vv.z & 0xffffu); VT[(seg * 8 + 5) * VS + key] = (bf16_t)(vv.z >> 16);
            VT[(seg * 8 + 6) * VS + key] = (bf16_t)(vv.w & 0xffffu); VT[(seg * 8 + 7) * VS + key] = (bf16_t)(vv.w >> 16); }
        __syncthreads();
#pragma unroll 1
        for (int kt = 0; kt < 4; ++kt) {
            f32x16 sc;
#pragma unroll
            for (int r = 0; r < 16; ++r) sc[r] = 0.f;
#pragma unroll
            for (int s = 0; s < 4; ++s) { const bf16x8 kf = *(const LAS bf16x8*)(KL + (kt * 32 + (lane & 31)) * KS + 16 * s + 8 * hh); sc = __builtin_amdgcn_mfma_f32_32x32x16_bf16(kf, qf[s], sc, 0, 0, 0); }
            if (mask) {
#pragma unroll
                for (int r = 0; r < 16; ++r) { const int kj = kt * 32 + (r & 3) + 8 * (r >> 2) + 4 * hh; const bool ok = mask == 1 ? (kj >= qi) : (kj <= qi); if (!ok) sc[r] = -INFINITY; }
            }
            float mx = sc[0];
#pragma unroll
            for (int r = 1; r < 16; ++r) mx = fmaxf(mx, sc[r]);
            mx = fmaxf(mx, __shfl_xor(mx, 32));
            const float mnew = fmaxf(mrun, mx); const float alpha = exp2f(mrun - mnew); mrun = mnew;
            float ps = 0.f; float p[16];
#pragma unroll
            for (int r = 0; r < 16; ++r) { p[r] = exp2f(sc[r] - mnew); ps += p[r]; }
            lrun = lrun * alpha + ps;
#pragma unroll
            for (int r = 0; r < 16; ++r) { o0[r] *= alpha; o1[r] *= alpha; }
#pragma unroll
            for (int s2 = 0; s2 < 2; ++s2) {
                bf16x8 pf; { u32x4 w; w.x = pk2(p[8 * s2 + 0], p[8 * s2 + 1]); w.y = pk2(p[8 * s2 + 2], p[8 * s2 + 3]); w.z = pk2(p[8 * s2 + 4], p[8 * s2 + 5]); w.w = pk2(p[8 * s2 + 6], p[8 * s2 + 7]); pf = __builtin_bit_cast(bf16x8, w); }
                const int kbase = kt * 32 + 16 * s2 + 4 * hh;
#pragma unroll
                for (int dh = 0; dh < 2; ++dh) {
                    const LAS bf16_t* vp = VT + (dh * 32 + (lane & 31)) * VS + kbase;
                    const u32x2 lo = *(const LAS u32x2*)vp, hi = *(const LAS u32x2*)(vp + 8);
                    u32x4 w; w.x = lo.x; w.y = lo.y; w.z = hi.x; w.w = hi.y; const bf16x8 vf = __builtin_bit_cast(bf16x8, w);
                    if (dh == 0) o0 = __builtin_amdgcn_mfma_f32_32x32x16_bf16(vf, pf, o0, 0, 0, 0); else o1 = __builtin_amdgcn_mfma_f32_32x32x16_bf16(vf, pf, o1, 0, 0, 0);
                }
            }
        }
    }
    const float ltot = lrun + __shfl_xor(lrun, 32); const float inv = 1.0f / ltot;
    bf16_t* orow = YA + (size_t)qrow * BW + head * 64;
#pragma unroll
    for (int g4 = 0; g4 < 4; ++g4) {
        const f32x4 v0 = (f32x4){o0[4 * g4], o0[4 * g4 + 1], o0[4 * g4 + 2], o0[4 * g4 + 3]} * inv, v1 = (f32x4){o1[4 * g4], o1[4 * g4 + 1], o1[4 * g4 + 2], o1[4 * g4 + 3]} * inv;
        *(u32x2*)(orow + 8 * g4 + 4 * hh) = f32_to_bf4(v0); *(u32x2*)(orow + 32 + 8 * g4 + 4 * hh) = f32_to_bf4(v1);
    }
    __syncthreads();
}

__device__ __forceinline__ void sgu_unit(const Args& a, int l, int u, LAS unsigned char* lds, int tid, int lane, int wave) {
    unsigned char* ws = a.ws;
    const bf16_t* GU = (const bf16_t*)(ws + WS_GU); const bf16_t* GV = (const bf16_t*)(ws + WS_GV); bf16_t* YB = (bf16_t*)(ws + WS_Y) + (size_t)TT * BW;
    constexpr int VS = 136;
    LAS bf16_t* VT = (LAS bf16_t*)lds;
    const int chunk = u >> 2, g = u & 3; const int r0 = chunk * 128;
    const float* lng = a.in[I_SLNG] + l * BW; const float* lnb = a.in[I_SLNB] + l * BW;
    __syncthreads();
    for (int t = 0; t < 16; ++t) {
        const int q = wave * 16 + t; const int row = r0 + q;
        const u32x4 raw = *(const u32x4*)(GV + (size_t)row * BW + lane * 8);
        float v[8] = {bflo(raw.x), bfhi(raw.x), bflo(raw.y), bfhi(raw.y), bflo(raw.z), bfhi(raw.z), bflo(raw.w), bfhi(raw.w)};
        float s = 0.f;
#pragma unroll
        for (int i = 0; i < 8; ++i) s += v[i];
        const float mu = wave_sum(s) * (1.0f / BW); float q2 = 0.f;
#pragma unroll
        for (int i = 0; i < 8; ++i) { v[i] -= mu; q2 += v[i] * v[i]; }
        const float rstd = 1.0f / sqrtf(wave_sum(q2) * (1.0f / BW) + 1e-5f);
        if ((lane >> 4) == g) { const int c0 = lane * 8; const int cl = (lane & 15) * 8;
#pragma unroll
            for (int i = 0; i < 8; ++i) { const float vn = v[i] * rstd * lng[c0 + i] + lnb[c0 + i]; VT[(cl + i) * VS + q] = (bf16_t)f2bf(vn); } }
    }
    __syncthreads();
    const float* Wsg = a.in[I_SGUW] + ((size_t)l * 4 + g) * 128 * 128;
    const int fr = lane & 15, fq = lane >> 4; const int pl = wave * 16 + fr;
    bf16x8 wf[4];
#pragma unroll
    for (int ks = 0; ks < 4; ++ks) { const f32x4 w0 = *(const f32x4*)(Wsg + (size_t)pl * 128 + 32 * ks + 8 * fq), w1 = *(const f32x4*)(Wsg + (size_t)pl * 128 + 32 * ks + 8 * fq + 4);
        u32x4 w; w.x = pk2(w0[0], w0[1]); w.y = pk2(w0[2], w0[3]); w.z = pk2(w1[0], w1[1]); w.w = pk2(w1[2], w1[3]); wf[ks] = __builtin_bit_cast(bf16x8, w); }
    const float bias = a.in[I_SGUB][((size_t)l * 4 + g) * 128 + pl];
    const int row = r0 + pl;
#pragma unroll
    for (int cg = 0; cg < 8; ++cg) {
        f32x4 acc = (f32x4){0.f, 0.f, 0.f, 0.f};
#pragma unroll
        for (int ks = 0; ks < 4; ++ks) { const bf16x8 vf = *(const LAS bf16x8*)(VT + (cg * 16 + fr) * VS + 32 * ks + 8 * fq); acc = __builtin_amdgcn_mfma_f32_16x16x32_bf16(vf, wf[ks], acc, 0, 0, 0); }
        const int c = g * 128 + cg * 16 + 4 * fq;
        const f32x4 gu = bf4_to_f32(*(const u32x2*)(GU + (size_t)row * BW + c));
        *(u32x2*)(YB + (size_t)row * BW + c) = f32_to_bf4(gu * (acc + bias));
    }
}

__device__ __forceinline__ bool seq_start(int row) { return row < TL ? ((row & 2047) == 0) : (((row - TL) & 255) == 0); }
__device__ __forceinline__ void conf_unit(const Args& a, int l, int u, LAS unsigned char* lds, int tid, int lane, int wave) {
    unsigned char* ws = a.ws;
    const bf16_t* Z = (const bf16_t*)(ws + WS_Z); bf16_t* YD = (bf16_t*)(ws + WS_Y) + (size_t)3 * TT * BW;
    LAS bf16_t* ZL = (LAS bf16_t*)lds;
    LAS float* OL = (LAS float*)(lds + 63488);
    LAS float* RED = (LAS float*)(lds + 63488 + 65536);
    LAS float* STAT = RED + 512;
    const int r0 = u * 32;
    const int ss = r0 < TL ? (r0 & ~2047) : TL + ((r0 - TL) & ~255); const int se = ss + (r0 < TL ? SEQ : LCTX);
    __syncthreads();
    for (int p = tid; p < 62 * 64; p += NTHR) { const int j = p >> 6, seg = p & 63; const int row = r0 - 15 + j;
        u32x4 v = (u32x4){0u, 0u, 0u, 0u}; if (row >= ss && row < se) v = *(const u32x4*)(Z + (size_t)row * BW + seg * 8);
        *(LAS u32x4*)(ZL + j * 512 + seg * 8) = v; }
    __syncthreads();
    const int c = tid;
    float w[31];
#pragma unroll
    for (int k = 0; k < 31; ++k) w[k] = a.in[I_CDW][((size_t)l * 31 + k) * BW + c];
    const float bias = a.in[I_CDB][l * BW + c];
#pragma unroll 1
    for (int i = 0; i < 32; ++i) {
        float o = bias;
#pragma unroll
        for (int k = 0; k < 31; ++k) o += w[k] * __builtin_bit_cast(float, (unsigned)ZL[(i + k) * 512 + c] << 16);
        OL[i * 512 + c] = o;
        const float s = wave_sum(o), q = wave_sum(o * o);
        if (lane == 0) { RED[wave * 64 + i] = s; RED[wave * 64 + 32 + i] = q; }
    }
    __syncthreads();
    if (tid < 32) { float s = 0.f, q = 0.f;
#pragma unroll
        for (int wv = 0; wv < 8; ++wv) { s += RED[wv * 64 + tid]; q += RED[wv * 64 + 32 + tid]; }
        const float mu = s * (1.0f / BW); const float var = fmaxf(q * (1.0f / BW) - mu * mu, 0.f); STAT[tid] = mu; STAT[32 + tid] = 1.0f / sqrtf(var + 1e-5f); }
    __syncthreads();
    const float lg = a.in[I_CLNG][l * BW + c], lb = a.in[I_CLNB][l * BW + c];
#pragma unroll 4
    for (int i = 0; i < 32; ++i) { const float y = (OL[i * 512 + c] - STAT[i]) * STAT[32 + i] * lg + lb; YD[(size_t)(r0 + i) * BW + c] = (bf16_t)f2bf(siluf_(y)); }
}

__device__ __forceinline__ void sconv_unit(const Args& a, int l, int u, int tid) {
    unsigned char* ws = a.ws;
    const bf16_t* CB = (const bf16_t*)(ws + WS_CB); const bf16_t* CU = (const bf16_t*)(ws + WS_CU); bf16_t* YC = (bf16_t*)(ws + WS_Y) + (size_t)2 * TT * BW;
    const float* W = a.in[I_SCW] + (size_t)l * 3 * BW;
#pragma unroll
    for (int i = 0; i < 4; ++i) { const int p = tid + 512 * i; const int row = u * 32 + (p >> 6), c0 = (p & 63) * 8;
        const bool hasp = !seq_start(row), hasn = (row + 1 < TT) && !seq_start(row + 1);
        const u32x4 z4 = (u32x4){0u, 0u, 0u, 0u};
        const u32x4 um = hasp ? *(const u32x4*)(CU + (size_t)(row - 1) * BW + c0) : z4, u0 = *(const u32x4*)(CU + (size_t)row * BW + c0), up = hasn ? *(const u32x4*)(CU + (size_t)(row + 1) * BW + c0) : z4;
        const u32x4 cb = *(const u32x4*)(CB + (size_t)row * BW + c0);
        const f32x4 wa0 = *(const f32x4*)(W + c0), wa1 = *(const f32x4*)(W + c0 + 4), wb0 = *(const f32x4*)(W + BW + c0), wb1 = *(const f32x4*)(W + BW + c0 + 4), wc0 = *(const f32x4*)(W + 2 * BW + c0), wc1 = *(const f32x4*)(W + 2 * BW + c0 + 4);
        const f32x4 y0 = bf4_to_f32((u32x2){cb.x, cb.y}) * (wa0 * bf4_to_f32((u32x2){um.x, um.y}) + wb0 * bf4_to_f32((u32x2){u0.x, u0.y}) + wc0 * bf4_to_f32((u32x2){up.x, up.y}));
        const f32x4 y1 = bf4_to_f32((u32x2){cb.z, cb.w}) * (wa1 * bf4_to_f32((u32x2){um.z, um.w}) + wb1 * bf4_to_f32((u32x2){u0.z, u0.w}) + wc1 * bf4_to_f32((u32x2){up.z, up.w}));
        const u32x2 a0 = f32_to_bf4(y0), a1 = f32_to_bf4(y1);
        *(u32x4*)(YC + (size_t)row * BW + c0) = (u32x4){a0.x, a0.y, a1.x, a1.y}; }
}

constexpr int N_PHASES = 18;
__global__ void __launch_bounds__(NTHR, 2) fwd_kernel(Args args) {
    extern __shared__ __attribute__((aligned(16))) unsigned char lds_raw[];
    LAS unsigned char* lds = (LAS unsigned char*)lds_raw;
    const int tid0 = threadIdx.x;
    const int G = gridDim.x, wg = blockIdx.x;
    unsigned char* ws = args.ws;
    unsigned* ctl = (unsigned*)(ws + WS_CTL);
    volatile LAS unsigned* MISC = (volatile LAS unsigned*)(lds + MISC_OFF);
    for (int u = tid0; u < (LDS_BYTES - LDSCTL_OFF) / 4; u += NTHR) ((LAS unsigned*)(lds + LDSCTL_OFF))[u] = 0u;
    __syncthreads();
    const int lo = args.ph_lo, hi = args.ph_hi;
    XcdBarrier bar; bar.bar = ctl + CW_BAR; bar.x = 0; bar.st = nullptr;
    if (hi - lo > 1) bar = xcd_barrier_post(ctl + CW_BAR, MISC + 8);
#ifndef PHASE_MASK
#define PHASE_MASK 0x3ff
#endif
#define PM(b) ((PHASE_MASK >> (b)) & 1)
#define IN(k) (lo <= (k) && (k) < hi)
#define FRESH_TID() int tid = threadIdx.x; asm volatile("" : "+v"(tid)); const int lane = tid & 63, wave = __builtin_amdgcn_readfirstlane(tid >> 6);
#define SEAM(k) do { if (IN(k) && IN((k) + 1)) xcd_barrier(bar); } while (0)

    if (PM(0) && IN(0)) { FRESH_TID(); p0_prologue(args, lds, tid, lane, wave, wg, G); }
    SEAM(0);
    for (int l = 0; l < 2; ++l) {
        const int P = 8 * l;
        const int nM = l == 0 ? 36 : 32;
        if (PM(1) && IN(P + 1)) { FRESH_TID(); if (l == 0) norm_phase<0>(args, lane, wave, wg, G); else norm_phase<1>(args, lane, wave, wg, G); }
        SEAM(P + 1);
        if (PM(2) && IN(P + 2)) {
            SchedWin S{(const bf16_t*)(ws + WS_H), (const bf16_t*)(ws + WS_WIN) + (size_t)l * NIN * D, nM, l == 0 ? 0 : 4, G, wg};
            EpiWin E{ws, (const float*)(ws + WS_ROPE)};
            pg8::gemm_phase<EpiWin, SchedWin, false>(lds, D, S, E);
        }
        SEAM(P + 2);
        if (PM(3) && IN(P + 3)) {
            const int nA = l == 0 ? 288 : 256, nS = nM * 8, nC = nM * 8;
            if (DBG_MIX & 1) { FRESH_TID(); for (int u = wg; u < nA; u += G) attn_unit(args, l, u, lds, tid, lane, wave); }
            if (DBG_MIX & 2) { FRESH_TID(); for (int u = (wg + G - 32) % G; u < nS; u += G) sgu_unit(args, l, u, lds, tid, lane, wave); }
            if (DBG_MIX & 4) { FRESH_TID(); for (int u = (wg + G - 64) % G; u < nC; u += G) conf_unit(args, l, u, lds, tid, lane, wave); }
            if (DBG_MIX & 8) { FRESH_TID(); for (int u = (wg + G - 96) % G; u < nC; u += G) sconv_unit(args, l, u, tid); }
        }
        SEAM(P + 3);
        if (PM(4) && IN(P + 4)) {
            SchedBranch S{(const bf16_t*)(ws + WS_Y), (const bf16_t*)(ws + WS_WB) + (size_t)l * 4 * D * BW, nM, G, wg};
            EpiBranch E{(const bf16_t*)(ws + WS_G), (float*)(ws + WS_MS) + (size_t)wg * 65536, (bf16_t*)(ws + WS_MG)};
            pg8::gemm_phase<EpiBranch, SchedBranch, false>(lds, BW, S, E);
        }
        SEAM(P + 4);
        if (PM(5) && IN(P + 5)) {
            SchedOut S{(const bf16_t*)(ws + WS_MG), (const bf16_t*)(ws + WS_WO) + (size_t)l * D * D, nM, G, wg};
            EpiOut E{l == 0 ? args.in[I_X] : (const float*)(ws + WS_XS), l == 0 ? args.in[I_CTX] : (const float*)(ws + WS_XS) + (size_t)TL * D, (float*)(ws + WS_XS), (const float*)(ws + WS_MOD) + (size_t)l * 5 * 12288 + 4096};
            pg8::gemm_phase<EpiOut, SchedOut, false>(lds, D, S, E);
        }
        SEAM(P + 5);
        if (PM(6) && IN(P + 6)) { FRESH_TID(); router_phase(args, l, lds, tid, lane, wave, wg, G); }
        SEAM(P + 6);
        if (PM(7) && IN(P + 7)) {
            { FRESH_TID(); moe_build_list(lds, ctl + CW_CNT + 64 * l, G, wg, tid); }
            SchedMoe<true> S{lds, (const bf16_t*)(ws + WS_H), (const bf16_t*)(ws + WS_WUP) + (size_t)l * NE * D * D, (const int*)(ws + WS_LT)};
            EpiUp E{(bf16_t*)(ws + WS_ACT)};
            pg8::gemm_phase<EpiUp, SchedMoe<true>, true>(lds, D, S, E);
        }
        SEAM(P + 7);
        if (PM(8) && IN(P + 8)) {
            { FRESH_TID(); moe_build_list(lds, ctl + CW_CNT + 64 * l, G, wg, tid); }
            SchedMoe<false> S{lds, (const bf16_t*)(ws + WS_ACT), (const bf16_t*)(ws + WS_WDN) + (size_t)l * NE * D * DFF, (const int*)(ws + WS_LT)};
            EpiDown E{(const int*)(ws + WS_LT), (const float*)(ws + WS_LW), (bf16_t*)(ws + WS_YT)};
            pg8::gemm_phase<EpiDown, SchedMoe<false>, false>(lds, DFF, S, E);
        }
        SEAM(P + 8);
    }
    if (PM(9) && IN(17)) { FRESH_TID(); norm_phase<2>(args, lane, wave, wg, G); }
#undef IN
#undef SEAM
}

extern "C" void kernel_launch(void* const* d_in, const int* in_sizes, int n_in, void* d_out, int out_size, void* d_ws, size_t ws_size, hipStream_t stream) {
    static int grid = 0;
    if (grid == 0) {
        if (n_in != 26 || out_size != TL * D || ws_size < WS_END) { fprintf(stderr, "kernel_launch: unexpected shapes (n_in %d, out %d, ws %zu < %zu)\n", n_in, out_size, ws_size, (size_t)WS_END); grid = -1; return; }
        int dev = 0, cus = 0, per_cu = 0;
        if (hipGetDevice(&dev) != hipSuccess || hipDeviceGetAttribute(&cus, hipDeviceAttributeMultiprocessorCount, dev) != hipSuccess) { grid = -1; return; }
        if (hipFuncSetAttribute((const void*)fwd_kernel, hipFuncAttributeMaxDynamicSharedMemorySize, LDS_BYTES) != hipSuccess) { fprintf(stderr, "kernel_launch: hipFuncSetAttribute failed\n"); grid = -1; return; }
        if (hipOccupancyMaxActiveBlocksPerMultiprocessor(&per_cu, (const void*)fwd_kernel, NTHR, LDS_BYTES) != hipSuccess || per_cu < 1) fprintf(stderr, "kernel_launch: occupancy query reports %d\n", per_cu);
        (void)hipGetLastError();
        grid = cus < 256 ? cus : 256;
    }
    if (grid < 0) return;
    (void)hipMemsetAsync((char*)d_ws + WS_CTL, 0, CTL_BYTES, stream);
    Args a{};
    for (int i = 0; i < 26; ++i) a.in[i] = (const float*)d_in[i];
    a.out = (float*)d_out; a.ws = (unsigned char*)d_ws;
#if MK_N_LAUNCHES == 1
    a.ph_lo = 0; a.ph_hi = N_PHASES;
    hipLaunchKernelGGL(fwd_kernel, dim3(grid), dim3(NTHR), LDS_BYTES, stream, a);
#else
#ifndef DBG_LAST
#define DBG_LAST N_PHASES
#endif
    for (int p = 0; p < DBG_LAST; ++p) { a.ph_lo = p; a.ph_hi = p + 1; hipLaunchKernelGGL(fwd_kernel, dim3(grid), dim3(NTHR), LDS_BYTES, stream, a); }
#endif
}
```

```cpp
#include <hip/hip_runtime.h>
#include <cstdio>
#include <cstdint>

#ifndef DBG_LAST
#define DBG_LAST 18
#endif
#ifndef DBG_MIX
#define DBG_MIX 15
#endif
#ifndef REP
#define REP 0
#endif
#ifndef MK_N_LAUNCHES
#define MK_N_LAUNCHES 1
#endif

#define LAS __attribute__((address_space(3)))
#define GAS __attribute__((address_space(1)))
typedef unsigned short bf16_t;
typedef short bf16x8 __attribute__((ext_vector_type(8)));
typedef float f32x4 __attribute__((ext_vector_type(4)));
typedef float f32x2 __attribute__((ext_vector_type(2)));
typedef float f32x16 __attribute__((ext_vector_type(16)));
typedef unsigned u32x4 __attribute__((ext_vector_type(4)));
typedef unsigned u32x2 __attribute__((ext_vector_type(2)));

constexpr int D = 2048, NBATCH = 4, SEQ = 2048, LCTX = 256;
constexpr int TL = NBATCH * SEQ;
constexpr int TC = NBATCH * LCTX;
constexpr int TT = TL + TC;
constexpr int NIN = 12544, NTIN = 49;
constexpr int BW = 512;
constexpr int NE = 16, DFF = 1024;
constexpr int NWAVES = 8, NTHR = 512;
constexpr float LOG2E = 1.4426950408889634f;
constexpr float QSCALE = 0.125f * LOG2E;

constexpr size_t al256(size_t x) { return (x + 255) & ~(size_t)255; }
constexpr size_t WS_CTL = 0, CTL_BYTES = 1u << 20;
constexpr size_t WS_MOD = WS_CTL + CTL_BYTES;
constexpr size_t WS_ROPE = WS_MOD + al256((size_t)2 * 5 * 12288 * 4);
constexpr size_t WS_WIN = WS_ROPE + al256(64 * 32 * 4);
constexpr size_t WS_WB = WS_WIN + (size_t)2 * NIN * D * 2;
constexpr size_t WS_WO = WS_WB + (size_t)2 * 4 * D * BW * 2;
constexpr size_t WS_WUP = WS_WO + (size_t)2 * D * D * 2;
constexpr size_t WS_WDN = WS_WUP + (size_t)32 * D * D * 2;
constexpr size_t WS_XS = WS_WDN + (size_t)32 * D * DFF * 2;
constexpr size_t WS_H = WS_XS + (size_t)TT * D * 4;
constexpr size_t WS_Q = WS_H + (size_t)TT * D * 2;
constexpr size_t WS_K = WS_Q + (size_t)TT * BW * 2;
constexpr size_t WS_V = WS_K + (size_t)TT * 128 * 2;
constexpr size_t WS_GU = WS_V + (size_t)TT * 128 * 2;
constexpr size_t WS_GV = WS_GU + (size_t)TT * BW * 2;
constexpr size_t WS_CB = WS_GV + (size_t)TT * BW * 2;
constexpr size_t WS_CU = WS_CB + (size_t)TT * BW * 2;
constexpr size_t WS_Z = WS_CU + (size_t)TT * BW * 2;
constexpr size_t WS_G = WS_Z + (size_t)TT * BW * 2;
constexpr size_t WS_Y = WS_G + (size_t)TT * 8192 * 2;
constexpr size_t WS_MS = WS_Y + (size_t)4 * TT * BW * 2;
constexpr size_t WS_MG = WS_MS + (size_t)256 * 65536 * 4;
constexpr size_t WS_LT = WS_MG + (size_t)TT * D * 2;
constexpr size_t WS_LW = WS_LT + (size_t)NE * TT * 4;
constexpr int ACT_ROWS = 2 * TT + NE * 256;
constexpr size_t WS_ACT = WS_LW + (size_t)NE * TT * 4;
constexpr size_t WS_YT = WS_ACT + (size_t)ACT_ROWS * DFF * 2;
constexpr size_t WS_END = WS_YT + (size_t)2 * TT * D * 2;
constexpr int CW_CNT = 64;
constexpr int CW_BAR = 8192;

constexpr int RING_BYTES = 131072;
constexpr int LDSCTL_OFF = 135168;
constexpr int MISC_OFF = LDSCTL_OFF + 320;
constexpr int LDS_BYTES = 147456;

__device__ __forceinline__ unsigned f2bf(float f) { unsigned u = __builtin_bit_cast(unsigned, f); return (u + 0x7fffu + ((u >> 16) & 1u)) >> 16; }
typedef __bf16 bf16x2_t __attribute__((ext_vector_type(2)));
__device__ __forceinline__ unsigned pk2(float lo, float hi) { const f32x2 v = {lo, hi}; const bf16x2_t b = __builtin_convertvector(v, bf16x2_t); return __builtin_bit_cast(unsigned, b); }
__device__ __forceinline__ float bflo(unsigned w) { return __builtin_bit_cast(float, w << 16); }
__device__ __forceinline__ float bfhi(unsigned w) { return __builtin_bit_cast(float, w & 0xffff0000u); }
__device__ __forceinline__ f32x4 bf4_to_f32(u32x2 w) { return (f32x4){bflo(w.x), bfhi(w.x), bflo(w.y), bfhi(w.y)}; }
__device__ __forceinline__ u32x2 f32_to_bf4(f32x4 v) { u32x2 w; w.x = pk2(v[0], v[1]); w.y = pk2(v[2], v[3]); return w; }
__device__ __forceinline__ float wave_sum(float v) {
#pragma unroll
    for (int o = 1; o < 64; o <<= 1) v += __shfl_xor(v, o);
    return v;
}
__device__ __forceinline__ float sigmoidf_(float x) { return __builtin_amdgcn_rcpf(1.0f + __builtin_amdgcn_exp2f(-LOG2E * x)); }
__device__ __forceinline__ float siluf_(float x) { return x * __builtin_amdgcn_rcpf(1.0f + __builtin_amdgcn_exp2f(-LOG2E * x)); }
__device__ __forceinline__ float geluf_(float x) { const float z = 0.7978845608028654f * (x + 0.044715f * x * x * x); return x * __builtin_amdgcn_rcpf(1.0f + __builtin_amdgcn_exp2f(-2.0f * LOG2E * z)); }
#define LDS_WAIT() asm volatile("s_waitcnt lgkmcnt(0)" ::: "memory")
#define VM_WAIT() asm volatile("s_waitcnt vmcnt(0)" ::: "memory")

__device__ __forceinline__ int lane_id() { return (int)__builtin_amdgcn_mbcnt_hi(~0u, __builtin_amdgcn_mbcnt_lo(~0u, 0u)); }
__device__ __forceinline__ unsigned char* launder_g(unsigned char* p) { size_t z = 0; asm volatile("" : "+s"(z)); return p + z; }
template <int N> __device__ __forceinline__ void wave_sum_n(float (&v)[N]) {
#pragma unroll
    for (int o = 1; o < 64; o <<= 1) {
        float t[N];
#pragma unroll
        for (int i = 0; i < N; ++i) t[i] = __shfl_xor(v[i], o);
#pragma unroll
        for (int i = 0; i < N; ++i) v[i] += t[i];
    }
}
__device__ __forceinline__ int mod_row(int row) { return row < TL ? (row >> 11) : 4; }

namespace pg8 {
constexpr int BM = 256, BK = 64, HALF = 128, HTB = HALF * BK * 2, STAGE_BYTES = 8 * HTB;
__host__ __device__ __forceinline__ int lds_byte(int r, int c) { const int st = (r >> 4) * 2 + (c >> 5), rr = r & 15, cc = c & 31, ob = rr * 64 + cc * 2; return st * 1024 + (ob ^ (((ob >> 9) & 1) << 5)); }
__host__ __device__ __forceinline__ void stage_rc(int b, int& R, int& C) { const int st = b / 1024, sb = b % 1024, swz = sb ^ (((sb >> 9) & 1) << 5); R = (st >> 1) * 16 + swz / 64; C = (st & 1) * 32 + (swz % 64) / 2; }

struct Unit { int pm, pn, z, rb, cnt; };

template <class Epi, class Sched, bool GATHER>
__device__ __forceinline__ void gemm_phase(LAS unsigned char* lds, const int K, const Sched& S, const Epi& E, const int wave_s) {
    int tid_l = wave_s * 64 + lane_id(); asm volatile("" : "+v"(tid_l));
    const int tid = tid_l, wid = __builtin_amdgcn_readfirstlane(tid >> 6), lane = tid & 63, wr = wid >> 2, wc = wid & 3, fr = lane & 15, fq = lane >> 4;
    const int nt = K / BK;
    unsigned voffA[2], voffB[2]; int sR[2], sC[2];
#pragma unroll
    for (int i = 0; i < 2; ++i) { int R, C; stage_rc(tid * 16 + i * 8192, R, C); sR[i] = R; sC[i] = C; voffA[i] = (unsigned)(R * K + C) * 2u; voffB[i] = voffA[i]; }
    const size_t kstep = (size_t)(BK * 2);
    const size_t hstep = (size_t)HALF * K * 2;
    const unsigned ldsw = (unsigned)wid * 1024u;
    const int aoff = lds_byte(wr * 64 + fr, fq * 8), boff = lds_byte(wc * 32 + fr, fq * 8);
#define PG8_SA(b, h) (((b) * 2 + (h)) * HTB)
#define PG8_SB(b, h) ((4 + (b) * 2 + (h)) * HTB)
#define PG8_STAGE(bufoff, gbase, voff) do { _Pragma("unroll") for (int _i = 0; _i < 2; ++_i) \
        __builtin_amdgcn_global_load_lds((const unsigned*)((const char*)(gbase) + (voff)[_i]), (LAS unsigned*)(lds + (bufoff) + ldsw + _i * 8192), 16, 0, 0); } while (0)
#define PG8_STAGE_A(bufoff, gbase, h, go) do { if constexpr (GATHER) { PG8_STAGE(bufoff, gbase, (go)[h]); } else { PG8_STAGE(bufoff, (gbase) + (h) * hstep, voffA); } } while (0)
#define PG8_LDA(dst, b, h) do { _Pragma("unroll") for (int m = 0; m < 4; ++m) _Pragma("unroll") for (int k = 0; k < 2; ++k) dst[m][k] = *(const LAS bf16x8*)(lds + PG8_SA(b, h) + aoff + m * 2048 + k * 1024); } while (0)
#define PG8_LDB(dst, b, h) do { _Pragma("unroll") for (int n = 0; n < 2; ++n) _Pragma("unroll") for (int k = 0; k < 2; ++k) dst[n][k] = *(const LAS bf16x8*)(lds + PG8_SB(b, h) + boff + n * 2048 + k * 1024); } while (0)
#define PG8_MMA(ai, bj, At, Bt) do { __builtin_amdgcn_s_setprio(1); _Pragma("unroll") for (int m = 0; m < 4; ++m) _Pragma("unroll") for (int n = 0; n < 2; ++n) _Pragma("unroll") for (int k = 0; k < 2; ++k) \
        acc[ai][bj][m][n] = __builtin_amdgcn_mfma_f32_16x16x32_bf16(Bt[n][k], At[m][k], acc[ai][bj][m][n], 0, 0, 0); __builtin_amdgcn_s_setprio(0); } while (0)
#define PG8_WAIT_V(n) asm volatile("s_waitcnt vmcnt(" #n ")" ::: "memory")
#define PG8_WAIT_L(n) asm volatile("s_waitcnt lgkmcnt(" #n ")" ::: "memory")
#define PG8_BAR __builtin_amdgcn_s_barrier()
#define PG8_SCHED __builtin_amdgcn_sched_barrier(0)
    Unit cur, nxt; int ui = 0;
    if (!S.next(0, cur)) return;
    f32x4 acc[2][2][4][2];
#pragma unroll
    for (int a = 0; a < 2; ++a)
#pragma unroll
        for (int b = 0; b < 2; ++b)
#pragma unroll
            for (int m = 0; m < 4; ++m)
#pragma unroll
                for (int n = 0; n < 2; ++n) acc[a][b][m][n] = (f32x4){0.f, 0.f, 0.f, 0.f};
    bf16x8 At[4][2], B0[2][2], B1[2][2];
    unsigned goC[2][2], goN[2][2];
    if constexpr (GATHER) S.a_offs(cur, sR, sC, K, goC); else { goC[0][0] = goC[0][1] = goC[1][0] = goC[1][1] = 0u; }
    const char* cA = S.a_base(cur); const char* cB = S.b_base(cur);
    PG8_STAGE(PG8_SB(0, 0), cB, voffB); PG8_STAGE(PG8_SB(0, 1), cB + hstep, voffB); PG8_STAGE_A(PG8_SA(0, 0), cA, 0, goC); PG8_STAGE_A(PG8_SA(0, 1), cA, 1, goC);
    if (wr == 1) PG8_BAR;
    PG8_WAIT_V(2); PG8_BAR;
    PG8_STAGE(PG8_SB(1, 0), cB + kstep, voffB); PG8_STAGE_A(PG8_SA(1, 0), cA + kstep, 0, goC); PG8_STAGE(PG8_SB(1, 1), cB + hstep + kstep, voffB);
    PG8_WAIT_V(6); PG8_BAR;
    for (;;) {
        const bool has_next = S.next(ui + 1, nxt);
        const char* nA = has_next ? S.a_base(nxt) : cA; const char* nB = has_next ? S.b_base(nxt) : cB;
        if constexpr (GATHER) { if (has_next) S.a_offs(nxt, sR, sC, K, goN); else { goN[0][0] = goC[0][0]; goN[0][1] = goC[0][1]; goN[1][0] = goC[1][0]; goN[1][1] = goC[1][1]; } }
        for (int t = 0; t < nt; t += 2) {
            const bool last = (t == nt - 2);
            const char* a1 = cA + (size_t)(t + 1) * kstep;
            const char* a2 = last ? nA : cA + (size_t)(t + 2) * kstep; const char* b2 = last ? nB : cB + (size_t)(t + 2) * kstep;
            const char* a3 = a2 + kstep; const char* b3 = b2 + kstep;
            unsigned goL[2][2];
            if constexpr (GATHER) { goL[0][0] = last ? goN[0][0] : goC[0][0]; goL[0][1] = last ? goN[0][1] : goC[0][1]; goL[1][0] = last ? goN[1][0] : goC[1][0]; goL[1][1] = last ? goN[1][1] : goC[1][1]; }
            PG8_LDB(B0, 0, 0); PG8_LDB(B1, 0, 1); PG8_SCHED; PG8_LDA(At, 0, 0); PG8_STAGE_A(PG8_SA(1, 1), a1, 1, goC);
            PG8_WAIT_V(8); PG8_WAIT_L(0); PG8_BAR; PG8_MMA(0, 0, At, B0); PG8_MMA(0, 1, At, B1); PG8_BAR; PG8_SCHED;
            PG8_LDA(At, 0, 1); PG8_STAGE(PG8_SB(0, 0), b2, voffB); PG8_STAGE(PG8_SB(0, 1), b2 + hstep, voffB); PG8_STAGE_A(PG8_SA(0, 0), a2, 0, goL);
            PG8_WAIT_V(8); PG8_WAIT_L(0); PG8_BAR; PG8_MMA(1, 0, At, B0); PG8_MMA(1, 1, At, B1); PG8_BAR; PG8_SCHED;
            PG8_LDB(B0, 1, 0); PG8_LDB(B1, 1, 1); PG8_SCHED; PG8_LDA(At, 1, 0); PG8_STAGE_A(PG8_SA(0, 1), a2, 1, goL);
            PG8_WAIT_V(8); PG8_WAIT_L(0); PG8_BAR; PG8_MMA(0, 0, At, B0); PG8_MMA(0, 1, At, B1); PG8_BAR; PG8_SCHED;
            PG8_LDA(At, 1, 1); PG8_STAGE(PG8_SB(1, 0), b3, voffB); PG8_STAGE(PG8_SB(1, 1), b3 + hstep, voffB); PG8_STAGE_A(PG8_SA(1, 0), a3, 0, goL);
            PG8_WAIT_V(8); PG8_WAIT_L(0); PG8_BAR; PG8_MMA(1, 0, At, B0); PG8_MMA(1, 1, At, B1); PG8_BAR; PG8_SCHED;
        }
        if (wr == 0) PG8_BAR;
        E(acc, cur, wr, wc, fr, fq);
        if (!has_next) break;
#pragma unroll
        for (int a = 0; a < 2; ++a)
#pragma unroll
            for (int b = 0; b < 2; ++b)
#pragma unroll
                for (int m = 0; m < 4; ++m)
#pragma unroll
                    for (int n = 0; n < 2; ++n) acc[a][b][m][n] = (f32x4){0.f, 0.f, 0.f, 0.f};
        cur = nxt; cA = nA; cB = nB; ++ui;
        if constexpr (GATHER) { goC[0][0] = goN[0][0]; goC[0][1] = goN[0][1]; goC[1][0] = goN[1][0]; goC[1][1] = goN[1][1]; }
        if (wr == 1) PG8_BAR;
    }
    PG8_WAIT_V(0);
    PG8_BAR;
#undef PG8_SA
#undef PG8_SB
#undef PG8_STAGE
#undef PG8_STAGE_A
#undef PG8_LDA
#undef PG8_LDB
#undef PG8_MMA
#undef PG8_WAIT_V
#undef PG8_WAIT_L
#undef PG8_BAR
#undef PG8_SCHED
}
}
using pg8::Unit;

__device__ __forceinline__ int xcd_remap(int L, int n) { const int q = n / 8, r = n % 8, x = L % 8, off = L / 8; return (x < r ? x * (q + 1) : r * (q + 1) + (x - r) * q) + off; }

struct SchedWin {
    const bf16_t* A; const bf16_t* Bt; int nM, extra, G, c;
    __device__ __forceinline__ bool next(int i, Unit& u) const {
        const int nmain = nM * NTIN, total = nmain + extra; const int L = i * G + c; if (L >= total) return false;
        const int id = xcd_remap(L, total); u.z = 0; u.rb = 0; u.cnt = 0;
        if (id < nmain) { const int nig = 8 * NTIN, gid = id / nig, fm = gid * 8, gsz = (nM - fm) < 8 ? (nM - fm) : 8; u.pm = fm + ((id % nig) % gsz); u.pn = (id % nig) / gsz; }
        else { u.pm = 32 + (id - nmain); u.pn = 2; }
        return true;
    }
    __device__ __forceinline__ const char* a_base(const Unit& u) const { return (const char*)A + (size_t)u.pm * 256 * D * 2; }
    __device__ __forceinline__ const char* b_base(const Unit& u) const { return (const char*)Bt + (size_t)u.pn * 256 * D * 2; }
    __device__ __forceinline__ void a_offs(const Unit&, const int (&)[2], const int (&)[2], int, unsigned (&)[2][2]) const {}
};
struct SchedBranch {
    const bf16_t* Y; const bf16_t* Wb; int nM, G, c;
    __device__ __forceinline__ bool next(int i, Unit& u) const {
        const int ng = nM * 8; const int L = (i >> 2) * G + c; if (L >= ng) return false;
        const int id = xcd_remap(L, ng); u.pm = id >> 3; u.pn = id & 7; u.z = i & 3; u.rb = 0; u.cnt = 0; return true;
    }
    __device__ __forceinline__ const char* a_base(const Unit& u) const { return (const char*)Y + ((size_t)u.z * TT + (size_t)u.pm * 256) * BW * 2; }
    __device__ __forceinline__ const char* b_base(const Unit& u) const { return (const char*)Wb + ((size_t)u.z * D + (size_t)u.pn * 256) * BW * 2; }
    __device__ __forceinline__ void a_offs(const Unit&, const int (&)[2], const int (&)[2], int, unsigned (&)[2][2]) const {}
};
struct SchedOut {
    const bf16_t* A; const bf16_t* Bt; int nM, G, c;
    __device__ __forceinline__ bool next(int i, Unit& u) const {
        const int nu = nM * 8; const int L = i * G + c; if (L >= nu) return false;
        const int id = xcd_remap(L, nu); u.pm = id >> 3; u.pn = id & 7; u.z = 0; u.rb = 0; u.cnt = 0; return true;
    }
    __device__ __forceinline__ const char* a_base(const Unit& u) const { return (const char*)A + (size_t)u.pm * 256 * D * 2; }
    __device__ __forceinline__ const char* b_base(const Unit& u) const { return (const char*)Bt + (size_t)u.pn * 256 * D * 2; }
    __device__ __forceinline__ void a_offs(const Unit&, const int (&)[2], const int (&)[2], int, unsigned (&)[2][2]) const {}
};
constexpr int ULIST_OFF = LDSCTL_OFF + 1024;
__device__ __forceinline__ void moe_build_list(LAS unsigned char* lds, const unsigned* cw, int G, int c, int tid) {
    if (tid < 8) {
        int cnt[NE]; int tp = 0;
#pragma unroll
        for (int e = 0; e < NE; ++e) { cnt[e] = (int)__hip_atomic_load(cw + 64 * e, __ATOMIC_RELAXED, __HIP_MEMORY_SCOPE_AGENT); tp += (cnt[e] + 255) >> 8; }
        const int total = tp * 8; const int L = tid * G + c;
        int pm = -1, pn = 0, z = 0, rb = 0, cn = 0;
        if (L < total) {
            const int id = xcd_remap(L, total); int acc = 0;
#pragma unroll
            for (int e = 0; e < NE; ++e) { const int p = (cnt[e] + 255) >> 8; if (id >= acc * 8 && id < (acc + p) * 8) { const int r = id - acc * 8; pn = r / p; pm = r % p; z = e; rb = acc * 256; cn = cnt[e]; } acc += p; }
        }
        LAS int* ul = (LAS int*)(lds + ULIST_OFF) + tid * 8;
        ul[0] = pm; ul[1] = pn; ul[2] = z; ul[3] = rb; ul[4] = cn;
    }
    __syncthreads();
}
template <bool UP>
struct SchedMoe {
    LAS unsigned char* lds; const bf16_t* A; const bf16_t* W; const int* LT;
    __device__ __forceinline__ bool next(int i, Unit& u) const {
        if (i >= 8) return false;
        const LAS int* ul = (const LAS int*)(lds + ULIST_OFF) + i * 8;
        const int pm = __builtin_amdgcn_readfirstlane(ul[0]); if (pm < 0) return false;
        u.pm = pm; u.pn = __builtin_amdgcn_readfirstlane(ul[1]); u.z = __builtin_amdgcn_readfirstlane(ul[2]); u.rb = __builtin_amdgcn_readfirstlane(ul[3]); u.cnt = __builtin_amdgcn_readfirstlane(ul[4]); return true;
    }
    __device__ __forceinline__ const char* a_base(const Unit& u) const { return UP ? (const char*)A : (const char*)A + ((size_t)u.rb + (size_t)u.pm * 256) * DFF * 2; }
    __device__ __forceinline__ const char* b_base(const Unit& u) const { return UP ? (const char*)W + ((size_t)u.z * D + (size_t)u.pn * 256) * D * 2 : (const char*)W + ((size_t)u.z * D + (size_t)u.pn * 256) * DFF * 2; }
    __device__ __forceinline__ void a_offs(const Unit& u, const int (&R)[2], const int (&C)[2], int K, unsigned (&o)[2][2]) const {
#pragma unroll
        for (int h = 0; h < 2; ++h)
#pragma unroll
            for (int i = 0; i < 2; ++i) { const int slot = u.pm * 256 + h * 128 + R[i]; int tok = 0; if (slot < u.cnt) tok = LT[(size_t)u.z * TT + slot] >> 1; o[h][i] = (unsigned)(tok * K + C[i]) * 2u; }
    }
};

struct EpiWin {
    unsigned char* ws; const float* rope;
    __device__ __forceinline__ void operator()(const f32x4 (&acc)[2][2][4][2], const Unit& u, int wr, int wc, int fr, int fq) const {
        const int row0 = u.pm * 256 + wr * 64 + fr; const int pn = u.pn; const int cw = wc * 32 + 4 * fq;
        if (pn <= 2) {
            const bool latent = u.pm < 32; const int half = wc & 1;
            bf16_t* Q = (bf16_t*)(ws + WS_Q); bf16_t* KV = (bf16_t*)(ws + WS_K);
#pragma unroll
            for (int ai = 0; ai < 2; ++ai)
#pragma unroll
                for (int m = 0; m < 4; ++m) {
                    const int row = row0 + ai * 128 + m * 16;
                    f32x4 cs = (f32x4){1.f, 1.f, 1.f, 1.f}, sn = (f32x4){0.f, 0.f, 0.f, 0.f};
                    if (latent) { const int t = row & 2047; const int p = half ? (t & 63) : (t >> 6); cs = *(const f32x4*)(rope + p * 32 + 4 * fq); sn = *(const f32x4*)(rope + p * 32 + 16 + 4 * fq); }
#pragma unroll
                    for (int bj = 0; bj < 2; ++bj) {
                        const f32x4 x1 = acc[ai][bj][m][0], x2 = acc[ai][bj][m][1];
                        if (pn < 2) {
                            const f32x4 o1 = (x1 * cs - x2 * sn) * QSCALE, o2 = (x2 * cs + x1 * sn) * QSCALE;
                            bf16_t* p = Q + (size_t)row * BW + pn * 256 + bj * 128 + cw;
                            *(u32x2*)p = f32_to_bf4(o1); *(u32x2*)(p + 16) = f32_to_bf4(o2);
                        } else if (bj == 0) {
                            const f32x4 o1 = x1 * cs - x2 * sn, o2 = x2 * cs + x1 * sn;
                            bf16_t* p = KV + (size_t)row * 128 + cw;
                            *(u32x2*)p = f32_to_bf4(o1); *(u32x2*)(p + 16) = f32_to_bf4(o2);
                        } else {
                            bf16_t* p = KV + (size_t)TT * 128 + (size_t)row * 128 + cw;
                            *(u32x2*)p = f32_to_bf4(x1); *(u32x2*)(p + 16) = f32_to_bf4(x2);
                        }
                    }
                    asm volatile("" ::: "memory");
                }
        } else if (pn <= 8) {
            bf16_t* O = (bf16_t*)(ws + WS_GU) + (size_t)((pn - 3) >> 1) * TT * BW; const int ct = ((pn - 3) & 1) * 256; const bool act = pn <= 6;
#pragma unroll
            for (int ai = 0; ai < 2; ++ai)
#pragma unroll
                for (int m = 0; m < 4; ++m) { const int row = row0 + ai * 128 + m * 16;
#pragma unroll
                    for (int bj = 0; bj < 2; ++bj)
#pragma unroll
                        for (int n = 0; n < 2; ++n) { f32x4 v = acc[ai][bj][m][n];
                            if (act) { v[0] = geluf_(v[0]); v[1] = geluf_(v[1]); v[2] = geluf_(v[2]); v[3] = geluf_(v[3]); }
                            *(u32x2*)(O + (size_t)row * BW + ct + bj * 128 + cw + 16 * n) = f32_to_bf4(v); }
                    asm volatile("" ::: "memory"); }
        } else if (pn <= 16) {
            const bool glu = pn >= 13; bf16_t* O = (bf16_t*)(ws + WS_CU) + (glu ? (size_t)TT * BW : (size_t)0); const int ct = ((pn - 9) & 3) * 128;
#pragma unroll
            for (int ai = 0; ai < 2; ++ai)
#pragma unroll
                for (int m = 0; m < 4; ++m) { const int row = row0 + ai * 128 + m * 16;
#pragma unroll
                    for (int n = 0; n < 2; ++n) { const f32x4 a = acc[ai][0][m][n], b = acc[ai][1][m][n]; f32x4 v;
                        if (glu) { v[0] = a[0] * sigmoidf_(b[0]); v[1] = a[1] * sigmoidf_(b[1]); v[2] = a[2] * sigmoidf_(b[2]); v[3] = a[3] * sigmoidf_(b[3]); } else v = a * b;
                        *(u32x2*)(O + (size_t)row * BW + ct + cw + 16 * n) = f32_to_bf4(v); }
                    asm volatile("" ::: "memory"); }
        } else {
            bf16_t* G = (bf16_t*)(ws + WS_G); const int ct = (pn - 17) * 256;
#pragma unroll
            for (int ai = 0; ai < 2; ++ai)
#pragma unroll
                for (int m = 0; m < 4; ++m) { const int row = row0 + ai * 128 + m * 16;
#pragma unroll
                    for (int bj = 0; bj < 2; ++bj)
#pragma unroll
                        for (int n = 0; n < 2; ++n) { f32x4 v = acc[ai][bj][m][n]; v[0] = sigmoidf_(v[0]); v[1] = sigmoidf_(v[1]); v[2] = sigmoidf_(v[2]); v[3] = sigmoidf_(v[3]);
                            *(u32x2*)(G + (size_t)row * 8192 + ct + bj * 128 + cw + 16 * n) = f32_to_bf4(v); }
                    asm volatile("" ::: "memory"); }
        }
    }
};
struct EpiBranch {
    const bf16_t* G; float* MS; bf16_t* MG;
    __device__ __forceinline__ void operator()(const f32x4 (&acc)[2][2][4][2], const Unit& u, int wr, int wc, int fr, int fq) const {
        const int row0 = u.pm * 256 + wr * 64 + fr; const int cw = wc * 32 + 4 * fq; const int z = u.z;
        int mi = (wr * 4 + wc) * 64 + fq * 16 + fr; asm volatile("" : "+v"(mi)); f32x4* ms = (f32x4*)MS + mi;
#pragma unroll
        for (int ai = 0; ai < 2; ++ai)
#pragma unroll
            for (int m = 0; m < 4; ++m) { const int row = row0 + ai * 128 + m * 16;
#pragma unroll
                for (int bj = 0; bj < 2; ++bj)
#pragma unroll
                    for (int n = 0; n < 2; ++n) {
                        const int col = u.pn * 256 + bj * 128 + cw + 16 * n; const int slot = ((ai * 4 + m) * 2 + bj) * 2 + n;
                        const f32x4 g = bf4_to_f32(*(const u32x2*)(G + (size_t)row * 8192 + z * 2048 + col));
                        f32x4 v = acc[ai][bj][m][n] * g;
                        if (z > 0) v += ms[slot * 512];
                        if (z < 3) ms[slot * 512] = v; else *(u32x2*)(MG + (size_t)row * D + col) = f32_to_bf4(v);
                    }
                asm volatile("" ::: "memory"); }
    }
};
struct EpiOut {
    const float* srcL; const float* srcC; float* XS; const float* g1;
    __device__ __forceinline__ void operator()(const f32x4 (&acc)[2][2][4][2], const Unit& u, int wr, int wc, int fr, int fq) const {
        const int row0 = u.pm * 256 + wr * 64 + fr; const int cw = wc * 32 + 4 * fq;
        const int mr = u.pm < 32 ? (u.pm >> 3) : 4; const float* gp = g1 + (size_t)mr * 12288;
        const float* src = u.pm < 32 ? srcL : srcC - (size_t)TL * D;
        f32x4 gv[2][2];
#pragma unroll
        for (int bj = 0; bj < 2; ++bj)
#pragma unroll
            for (int n = 0; n < 2; ++n) gv[bj][n] = *(const f32x4*)(gp + u.pn * 256 + bj * 128 + cw + 16 * n);
#pragma unroll
        for (int ai = 0; ai < 2; ++ai)
#pragma unroll
            for (int m = 0; m < 4; ++m) { const size_t off = (size_t)(row0 + ai * 128 + m * 16) * D + u.pn * 256 + cw;
#pragma unroll
                for (int bj = 0; bj < 2; ++bj)
#pragma unroll
                    for (int n = 0; n < 2; ++n) { const f32x4 s = *(const f32x4*)(src + off + bj * 128 + 16 * n); *(f32x4*)(XS + off + bj * 128 + 16 * n) = s + gv[bj][n] * acc[ai][bj][m][n]; }
                asm volatile("" ::: "memory"); }
    }
};
struct EpiUp {
    bf16_t* ACT;
    __device__ __forceinline__ void operator()(const f32x4 (&acc)[2][2][4][2], const Unit& u, int wr, int wc, int fr, int fq) const {
        const int row0 = u.rb + u.pm * 256 + wr * 64 + fr; const int cw = wc * 32 + 4 * fq;
#pragma unroll
        for (int ai = 0; ai < 2; ++ai)
#pragma unroll
            for (int m = 0; m < 4; ++m) { const int row = row0 + ai * 128 + m * 16;
#pragma unroll
                for (int n = 0; n < 2; ++n) { const f32x4 a = acc[ai][0][m][n], b = acc[ai][1][m][n]; f32x4 v;
                    v[0] = siluf_(a[0]) * b[0]; v[1] = siluf_(a[1]) * b[1]; v[2] = siluf_(a[2]) * b[2]; v[3] = siluf_(a[3]) * b[3];
                    *(u32x2*)(ACT + (size_t)row * DFF + u.pn * 128 + cw + 16 * n) = f32_to_bf4(v); } }
    }
};
struct EpiDown {
    const int* LT; const float* LW; bf16_t* YT;
    __device__ __forceinline__ void operator()(const f32x4 (&acc)[2][2][4][2], const Unit& u, int wr, int wc, int fr, int fq) const {
        const int s0 = u.pm * 256 + wr * 64 + fr; const int cw = wc * 32 + 4 * fq;
#pragma unroll
        for (int ai = 0; ai < 2; ++ai)
#pragma unroll
            for (int m = 0; m < 4; ++m) { const int slot = s0 + ai * 128 + m * 16;
                if (slot < u.cnt) { const int tj = LT[(size_t)u.z * TT + slot]; const float w = LW[(size_t)u.z * TT + slot];
#pragma unroll
                    for (int bj = 0; bj < 2; ++bj)
#pragma unroll
                        for (int n = 0; n < 2; ++n) *(u32x2*)(YT + (size_t)tj * D + u.pn * 256 + bj * 128 + cw + 16 * n) = f32_to_bf4(acc[ai][bj][m][n] * w); } }
    }
};

#define XB_TMO      128
#define XB_XCNT(j)  (256  + 64 * (j))
#define XB_XSUB(j)  (1280 + 64 * (j))
#define XB_XGEN(j)  (2304 + 64 * (j))
#define XB_TOP      3328
#define XB_TOPGEN   3392
#define XCD_BAR_WORDS 3456
#define XB_SPIN_CAP (1u << 22)
__device__ __forceinline__ unsigned xb_ld(unsigned* p)              { return __hip_atomic_load(p, __ATOMIC_RELAXED, __HIP_MEMORY_SCOPE_AGENT); }
__device__ __forceinline__ unsigned xb_add(unsigned* p, unsigned v) { return __hip_atomic_fetch_add(p, v, __ATOMIC_RELAXED, __HIP_MEMORY_SCOPE_AGENT); }
__device__ __forceinline__ unsigned xb_xcc_id() { return (unsigned)__builtin_amdgcn_s_getreg((3 << 11) | 20) & 0xFu; }
#define XB_SPIN(cond, bar) do { unsigned _sp = 0; while (cond) { __builtin_amdgcn_s_sleep(1); \
    if ((++_sp & 255u) == 0u) { if (xb_ld(&(bar)[XB_TMO])) break; if (_sp > XB_SPIN_CAP) { atomicAdd(&(bar)[XB_TMO], 1u); break; } } } } while (0)
struct XcdBarrier { unsigned* bar; unsigned x; volatile LAS unsigned* st; };
__device__ __forceinline__ XcdBarrier xcd_barrier_post(unsigned* bar, volatile LAS unsigned* st, bool t0) {
    XcdBarrier b; b.bar = bar; b.x = xb_xcc_id(); b.st = st;
    if (t0) (void)xb_add(&bar[XB_XCNT(b.x)], 1u);
    return b;
}
__device__ __forceinline__ void xcd_barrier_complete(unsigned* bar, unsigned x, unsigned& nloc, unsigned& nx) {
    const unsigned G = gridDim.x * gridDim.y * gridDim.z;
    unsigned sum, cnt, mine, sp = 0u;
    for (;;) {
        sum = 0u; cnt = 0u; mine = 0u;
#pragma unroll
        for (unsigned j = 0; j < 16; ++j) { const unsigned c = xb_ld(&bar[XB_XCNT(j)]); sum += c; cnt += (c > 0u) ? 1u : 0u; mine = (j == x) ? c : mine; }
        if (sum == G) break;
        __builtin_amdgcn_s_sleep(1);
        if ((++sp & 255u) == 0u) { if (xb_ld(&bar[XB_TMO])) break; if (sp > XB_SPIN_CAP) { atomicAdd(&bar[XB_TMO], 1u); break; } }
    }
    nloc = mine > 0u ? mine : 1u; nx = cnt > 0u ? cnt : 1u;
}
__device__ __forceinline__ void xcd_barrier(const XcdBarrier& b, bool t0) {
    asm volatile("s_waitcnt vmcnt(0)" ::: "memory");
    __syncthreads();
    if (t0) {
        unsigned* bar = b.bar;
        __builtin_amdgcn_s_waitcnt(0);
        unsigned nloc = b.st[0], nx = b.st[1];
        if (nloc == 0u) { xcd_barrier_complete(bar, b.x, nloc, nx); b.st[0] = nloc; b.st[1] = nx; }
        const unsigned old = xb_add(&bar[XB_XSUB(b.x)], 1u);
        const unsigned gen = old / nloc;
        if (old + 1u == (gen + 1u) * nloc) {
            __builtin_amdgcn_fence(__ATOMIC_RELEASE, "agent");
            asm volatile("s_waitcnt vmcnt(0)" ::: "memory");
            const unsigned og = xb_add(&bar[XB_TOP], 1u);
            const unsigned tg = og / nx;
            if (og + 1u == (tg + 1u) * nx) xb_add(&bar[XB_TOPGEN], 1u);
            else XB_SPIN(xb_ld(&bar[XB_TOPGEN]) == tg, bar);
            __builtin_amdgcn_fence(__ATOMIC_ACQUIRE, "agent");
            xb_add(&bar[XB_XGEN(b.x)], 1u);
            asm volatile("s_waitcnt vmcnt(0)" ::: "memory");
        } else {
            XB_SPIN(xb_ld(&bar[XB_XGEN(b.x)]) == gen, bar);
            __builtin_amdgcn_fence(__ATOMIC_ACQUIRE, "agent");
            asm volatile("s_waitcnt vmcnt(0)" ::: "memory");
        }
    }
    __syncthreads();
}

struct Args { const float* in[26]; float* out; unsigned char* ws; int ph_lo, ph_hi; };
enum { I_X = 0, I_C, I_CTX, I_CCTX, I_ADAW, I_ADAB, I_N1G, I_N2G, I_WIN, I_SINK, I_SLNG, I_SLNB, I_SGUW, I_SGUB, I_SCW, I_CDW, I_CDB, I_CLNG, I_CLNB, I_WBR, I_WOUT, I_RW, I_RB, I_WUP, I_WDN, I_FG };

__device__ __forceinline__ void transpose_item(const float* W, int K, int N, bf16_t* WT, int k0, int s0, int n0, LAS float* scr, int lane) {
#pragma unroll
    for (int i = 0; i < 32; ++i) { const int kk = 2 * i + (lane >> 5); scr[kk * 33 + (lane & 31)] = __builtin_nontemporal_load(W + (size_t)(k0 + kk) * N + s0 + (lane & 31)); }
    LDS_WAIT(); asm volatile("" ::: "memory");
    const int c = lane & 7;
#pragma unroll
    for (int j = 0; j < 4; ++j) { const int n = (lane >> 3) + 8 * j; const LAS float* s = scr + (8 * c) * 33 + n;
        u32x4 o; o.x = pk2(s[0 * 33], s[1 * 33]); o.y = pk2(s[2 * 33], s[3 * 33]); o.z = pk2(s[4 * 33], s[5 * 33]); o.w = pk2(s[6 * 33], s[7 * 33]);
        __builtin_nontemporal_store(o, (u32x4*)(WT + (size_t)(n0 + n) * K + k0 + 8 * c)); }
    LDS_WAIT(); asm volatile("" ::: "memory");
}
__device__ __forceinline__ int win_src(int n) {
    const int pn = n >> 8, j = n & 255;
    if (pn < 9) return n;
    if (pn < 13) { const int t = pn - 9; return j < 128 ? 2304 + t * 128 + j : 2816 + t * 128 + (j - 128); }
    if (pn < 17) { const int t = pn - 13; return j < 128 ? 3328 + t * 128 + j : 3840 + t * 128 + (j - 128); }
    return n;
}
__device__ __forceinline__ int up_src(int n) { const int pn = n >> 8, j = n & 255; return j < 128 ? pn * 128 + j : 1024 + pn * 128 + (j - 128); }

__device__ __forceinline__ void p0_prologue(const Args& a, LAS unsigned char* lds, int tid, int lane, int wave, int wg, int G) {
    unsigned char* ws = launder_g(a.ws);
    __syncthreads();
    if (wg == 0) {
        float* rope = (float*)(ws + WS_ROPE);
        for (int idx = tid; idx < 64 * 16; idx += NTHR) { const int p = idx >> 4, j = idx & 15; const float inv = 1.0f / powf(10000.0f, (float)(2 * j) / 32.0f); const float ang = (float)p * inv; float s, c; sincosf(ang, &s, &c); rope[p * 32 + j] = c; rope[p * 32 + 16 + j] = s; }
    }
    {
        LAS float* SC = (LAS float*)lds;
        LAS float* RED = (LAS float*)(lds + 40960);
        for (int idx = tid; idx < 5 * D; idx += NTHR) { const int r = idx >> 11, k = idx & 2047; const float v = r < 4 ? a.in[I_C][r * D + k] : a.in[I_CCTX][k]; SC[idx] = siluf_(v); }
        __syncthreads();
        float* MOD = (float*)(ws + WS_MOD);
        for (int it = wg; it < 768; it += G) {
            const int l = it / 384, ch = it % 384; const int col = ch * 32 + (lane & 31); const int kp = lane >> 5;
            const float* W = a.in[I_ADAW] + (size_t)l * D * 12288 + col;
            float s0 = 0.f, s1 = 0.f, s2 = 0.f, s3 = 0.f, s4 = 0.f;
#pragma unroll 16
            for (int i = 0; i < 128; ++i) { const int k = wave * 256 + 2 * i + kp; const float w = W[(size_t)k * 12288];
                s0 += SC[k] * w; s1 += SC[2048 + k] * w; s2 += SC[4096 + k] * w; s3 += SC[6144 + k] * w; s4 += SC[8192 + k] * w; }
            s0 += __shfl_xor(s0, 32); s1 += __shfl_xor(s1, 32); s2 += __shfl_xor(s2, 32); s3 += __shfl_xor(s3, 32); s4 += __shfl_xor(s4, 32);
            if (lane < 32) { RED[(wave * 5 + 0) * 32 + lane] = s0; RED[(wave * 5 + 1) * 32 + lane] = s1; RED[(wave * 5 + 2) * 32 + lane] = s2; RED[(wave * 5 + 3) * 32 + lane] = s3; RED[(wave * 5 + 4) * 32 + lane] = s4; }
            __syncthreads();
            if (tid < 160) { const int r = tid >> 5, cc = tid & 31; float s = 0.f;
#pragma unroll
                for (int w = 0; w < 8; ++w) s += RED[(w * 5 + r) * 32 + cc];
                MOD[((size_t)l * 5 + r) * 12288 + ch * 32 + cc] = s + a.in[I_ADAB][l * 12288 + ch * 32 + cc]; }
            __syncthreads();
        }
    }
    {
        LAS float* scr = (LAS float*)(lds + wave * 16384);
        const int gw = wg * NWAVES + wave, NGW = G * NWAVES;
        constexpr int I_IN = 2 * 32 * (NIN / 32), I_BR = 8 * 8 * 64, I_OUT = 2 * 32 * 64, I_UP = 32 * 32 * 64, I_DN = 32 * 16 * 64;
        constexpr int NITEMS = I_IN + I_BR + I_OUT + I_UP + I_DN;
        for (int it = gw; it < NITEMS; it += NGW) {
            int r = it;
            if (r < I_IN) { const int per = 32 * (NIN / 32); const int l = r / per; r %= per; const int kb = r / (NIN / 32), nb = r % (NIN / 32);
                transpose_item(a.in[I_WIN] + (size_t)l * D * NIN, D, NIN, (bf16_t*)(ws + WS_WIN) + (size_t)l * NIN * D, kb * 64, win_src(nb * 32), nb * 32, scr, lane); continue; }
            r -= I_IN;
            if (r < I_BR) { const int mz = r / 512; r %= 512; const int kb = r / 64, nb = r % 64;
                transpose_item(a.in[I_WBR] + (size_t)mz * BW * D, BW, D, (bf16_t*)(ws + WS_WB) + (size_t)mz * D * BW, kb * 64, nb * 32, nb * 32, scr, lane); continue; }
            r -= I_BR;
            if (r < I_OUT) { const int l = r / 2048; r %= 2048; const int kb = r / 64, nb = r % 64;
                transpose_item(a.in[I_WOUT] + (size_t)l * D * D, D, D, (bf16_t*)(ws + WS_WO) + (size_t)l * D * D, kb * 64, nb * 32, nb * 32, scr, lane); continue; }
            r -= I_OUT;
            if (r < I_UP) { const int le = r / 2048; r %= 2048; const int kb = r / 64, nb = r % 64;
                transpose_item(a.in[I_WUP] + (size_t)le * D * D, D, D, (bf16_t*)(ws + WS_WUP) + (size_t)le * D * D, kb * 64, up_src(nb * 32), nb * 32, scr, lane); continue; }
            r -= I_UP;
            { const int le = r / 1024; r %= 1024; const int kb = r / 64, nb = r % 64;
                transpose_item(a.in[I_WDN] + (size_t)le * DFF * D, DFF, D, (bf16_t*)(ws + WS_WDN) + (size_t)le * D * DFF, kb * 64, nb * 32, nb * 32, scr, lane); }
        }
    }
}

template <int MODE>
__device__ __forceinline__ void norm_phase(const Args& a, int lane, int wave, int wg, int G) {
    unsigned char* ws = launder_g(a.ws);
    const float* MOD = (const float*)(ws + WS_MOD);
    float* XS = (float*)(ws + WS_XS); bf16_t* H = (bf16_t*)(ws + WS_H); const bf16_t* YT = (const bf16_t*)(ws + WS_YT);
    const int nrows = MODE == 2 ? TL : TT;
    const int gw = wg * NWAVES + wave, NGW = G * NWAVES;
    for (int row = gw; row < nrows; row += NGW) {
        const int mr = mod_row(row);
        const float* src = MODE == 0 ? (row < TL ? a.in[I_X] + (size_t)row * D : a.in[I_CTX] + (size_t)(row - TL) * D) : XS + (size_t)row * D;
        f32x4 x[8]; float ss = 0.f;
#pragma unroll
        for (int j = 0; j < 8; ++j) x[j] = *(const f32x4*)(src + 256 * j + 4 * lane);
        if (MODE != 0) {
            const float* g2 = MOD + ((size_t)0 * 5 + mr) * 12288 + 10240;
            const float* g2p = MODE == 1 ? g2 : g2 + (size_t)5 * 12288;
#pragma unroll
            for (int j = 0; j < 8; ++j) {
                const f32x4 y0 = bf4_to_f32(*(const u32x2*)(YT + (size_t)(2 * row) * D + 256 * j + 4 * lane)), y1 = bf4_to_f32(*(const u32x2*)(YT + (size_t)(2 * row + 1) * D + 256 * j + 4 * lane));
                const f32x4 g = *(const f32x4*)(g2p + 256 * j + 4 * lane);
                x[j] += g * (y0 + y1);
            }
            if (MODE == 1) {
#pragma unroll
                for (int j = 0; j < 8; ++j) *(f32x4*)(XS + (size_t)row * D + 256 * j + 4 * lane) = x[j];
            }
        }
#pragma unroll
        for (int j = 0; j < 8; ++j) ss += (x[j][0] * x[j][0] + x[j][1] * x[j][1]) + (x[j][2] * x[j][2] + x[j][3] * x[j][3]);
        const float rstd = 1.0f / sqrtf(wave_sum(ss) * (1.0f / D) + 1e-6f);
        if (MODE == 2) {
#pragma unroll
            for (int j = 0; j < 8; ++j) { const f32x4 g = *(const f32x4*)(a.in[I_FG] + 256 * j + 4 * lane); *(f32x4*)(a.out + (size_t)row * D + 256 * j + 4 * lane) = x[j] * rstd * g; }
        } else {
            const int l = MODE;
            const float* m = MOD + ((size_t)l * 5 + mr) * 12288; const float* gn = a.in[I_N1G] + (size_t)l * D;
#pragma unroll
            for (int j = 0; j < 8; ++j) { const int c = 256 * j + 4 * lane; const f32x4 g = *(const f32x4*)(gn + c), sh = *(const f32x4*)(m + c), sc = *(const f32x4*)(m + 2048 + c);
                const f32x4 h = x[j] * rstd * g * (sc + 1.0f) + sh; *(u32x2*)(H + (size_t)row * D + c) = f32_to_bf4(h); }
        }
    }
}

__device__ __forceinline__ void router_phase(const Args& a, int l, LAS unsigned char* lds, int tid, int lane, int wave, int wg, int G, int cset) {
    unsigned char* ws = launder_g(a.ws);
    constexpr int RWS = 2052;
    LAS float* RWT = (LAS float*)lds;
    LAS int* RE = (LAS int*)(lds + 16 * RWS * 4);
    LAS float* RWGT = (LAS float*)(lds + 16 * RWS * 4 + 512);
    LAS int* RBASE = (LAS int*)(lds + 16 * RWS * 4 + 1024);
    LAS float* LG = (LAS float*)(lds + 16 * RWS * 4 + 1280);
    const int nrows = l == 0 ? TT : TL; const int rpw = nrows / G;
    {
        f32x4 rv[16];
#pragma unroll
        for (int i = 0; i < 16; ++i) rv[i] = *(const f32x4*)(a.in[I_RW] + (size_t)(tid + NTHR * i) * 4);
#pragma unroll
        for (int i = 0; i < 16; ++i) { const int q = tid + NTHR * i; const int k = q >> 2, e4 = (q & 3) * 4;
            RWT[(e4 + 0) * RWS + k] = rv[i][0]; RWT[(e4 + 1) * RWS + k] = rv[i][1]; RWT[(e4 + 2) * RWS + k] = rv[i][2]; RWT[(e4 + 3) * RWS + k] = rv[i][3]; }
    }
    __syncthreads();
    const float* MOD = (const float*)(ws + WS_MOD) + (size_t)l * 5 * 12288;
    const float* XS = (const float*)(ws + WS_XS); bf16_t* H = (bf16_t*)(ws + WS_H); const float* gn = a.in[I_N2G] + (size_t)l * D;
    for (int rl = wave; rl < rpw; rl += NWAVES) {
        const int row = wg * rpw + rl; const int mr = mod_row(row); const float* m = MOD + (size_t)mr * 12288;
        f32x4 x[8]; float ss = 0.f;
#pragma unroll
        for (int j = 0; j < 8; ++j) { x[j] = *(const f32x4*)(XS + (size_t)row * D + 256 * j + 4 * lane); ss += (x[j][0] * x[j][0] + x[j][1] * x[j][1]) + (x[j][2] * x[j][2] + x[j][3] * x[j][3]); }
        const float rstd = 1.0f / sqrtf(wave_sum(ss) * (1.0f / D) + 1e-6f);
#pragma unroll
        for (int j = 0; j < 8; ++j) { const int c = 256 * j + 4 * lane; const f32x4 g = *(const f32x4*)(gn + c), sh = *(const f32x4*)(m + 6144 + c), sc = *(const f32x4*)(m + 8192 + c);
            x[j] = x[j] * rstd * g * (sc + 1.0f) + sh; *(u32x2*)(H + (size_t)row * D + c) = f32_to_bf4(x[j]); }
        float lg[NE];
#pragma unroll
        for (int e = 0; e < NE; ++e) { f32x4 wv[8];
#pragma unroll
            for (int j = 0; j < 8; ++j) wv[j] = *(const LAS f32x4*)(RWT + e * RWS + 256 * j + 4 * lane);
            float s = 0.f;
#pragma unroll
            for (int j = 0; j < 8; ++j) s += (x[j][0] * wv[j][0] + x[j][1] * wv[j][1]) + (x[j][2] * wv[j][2] + x[j][3] * wv[j][3]);
            lg[e] = s; }
        wave_sum_n<NE>(lg);
        if (lane < NE) {
            float mine = lg[0];
#pragma unroll
            for (int e = 1; e < NE; ++e) mine = lane == e ? lg[e] : mine;
            LG[rl * NE + lane] = mine; }
    }
    __syncthreads();
    if (tid < rpw) {
        float lg[NE];
#pragma unroll
        for (int e = 0; e < NE; ++e) lg[e] = LG[tid * NE + e];
        float mx = lg[0];
#pragma unroll
        for (int e = 1; e < NE; ++e) mx = fmaxf(mx, lg[e]);
        float sc_[NE], den = 0.f;
#pragma unroll
        for (int e = 0; e < NE; ++e) { sc_[e] = expf(lg[e] - mx); den += sc_[e]; }
        float bi[NE];
#pragma unroll
        for (int e = 0; e < NE; ++e) { sc_[e] = sc_[e] / den; bi[e] = sc_[e] + a.in[I_RB][e]; }
        float bestg = -3.0e38f; int gsel = 0;
#pragma unroll
        for (int g = 0; g < 4; ++g) { float m1 = -3.0e38f, m2 = -3.0e38f;
#pragma unroll
            for (int q = 0; q < 4; ++q) { const float v = bi[g * 4 + q]; if (v > m1) { m2 = m1; m1 = v; } else if (v > m2) m2 = v; }
            const float gs = m1 + m2; if (gs > bestg) { bestg = gs; gsel = g; } }
        float b0 = -3.0e38f, b1 = -3.0e38f, s0 = 0.f, s1 = 0.f; int i0 = 0, i1 = 0;
#pragma unroll
        for (int e = 0; e < NE; ++e) if ((e >> 2) == gsel) { const float v = bi[e];
            if (v > b0) { b1 = b0; i1 = i0; s1 = s0; b0 = v; i0 = e; s0 = sc_[e]; } else if (v > b1) { b1 = v; i1 = e; s1 = sc_[e]; } }
        RE[tid * 2] = i0; RE[tid * 2 + 1] = i1; const float inv = 1.0f / (s0 + s1); RWGT[tid * 2] = s0 * inv; RWGT[tid * 2 + 1] = s1 * inv;
    }
    __syncthreads();
    unsigned* cw = (unsigned*)(ws + WS_CTL) + CW_CNT + 1024 * l + 2048 * cset;
    if (tid < NE) { int n = 0; for (int i = 0; i < 2 * rpw; ++i) n += (RE[i] == tid) ? 1 : 0; RBASE[tid] = n ? (int)__hip_atomic_fetch_add(cw + 64 * tid, (unsigned)n, __ATOMIC_RELAXED, __HIP_MEMORY_SCOPE_AGENT) : 0; }
    __syncthreads();
    if (tid < 2 * rpw) { const int e = RE[tid]; int rank = RBASE[e]; for (int i = 0; i < tid; ++i) rank += (RE[i] == e) ? 1 : 0;
        const int row = wg * rpw + (tid >> 1);
        ((int*)(ws + WS_LT))[(size_t)e * TT + rank] = row * 2 + (tid & 1); ((float*)(ws + WS_LW))[(size_t)e * TT + rank] = RWGT[tid]; }
    __syncthreads();
}

__device__ __forceinline__ void attn_unit(const Args& a, int l, int u, LAS unsigned char* lds, int tid_in, int lane_in, int wave) {
    int tid = tid_in; asm volatile("" : "+v"(tid)); const int lane = tid & 63; (void)lane_in;
    unsigned char* ws = launder_g(a.ws);
    const bf16_t* Q = (const bf16_t*)(ws + WS_Q); const bf16_t* KB = (const bf16_t*)(ws + WS_K); const bf16_t* VB = (const bf16_t*)(ws + WS_V);
    bf16_t* YA = (bf16_t*)(ws + WS_Y);
    constexpr int KS = 72, VS = 136;
    LAS bf16_t* KL = (LAS bf16_t*)lds;
    LAS bf16_t* VT = (LAS bf16_t*)(lds + 128 * KS * 2);
    int b, g, hp, qrow0, nb = 0; bool isctx;
    if (u < 256) { hp = u & 1; g = (u >> 1) & 1; nb = (u >> 2) & 15; b = u >> 6; qrow0 = b * SEQ + nb * 128; isctx = false; }
    else { const int v = u - 256; hp = v & 1; g = (v >> 1) & 1; const int cb = (v >> 2) & 1; b = v >> 3; qrow0 = TL + b * LCTX + cb * 128; isctx = true; }
    const int head = g * 4 + hp * 2 + (wave >> 2); const int qi = (wave & 3) * 32 + (lane & 31); const int hh = lane >> 5;
    const int qrow = qrow0 + qi;
    bf16x8 qf[4];
#pragma unroll
    for (int s = 0; s < 4; ++s) qf[s] = *(const bf16x8*)(Q + (size_t)qrow * BW + head * 64 + 16 * s + 8 * hh);
    const float sink2 = a.in[I_SINK][l * 8 + head] * LOG2E;
    float mrun = sink2, lrun = (lane < 32) ? 1.0f : 0.0f;
    f32x16 o0, o1;
#pragma unroll
    for (int r = 0; r < 16; ++r) { o0[r] = 0.f; o1[r] = 0.f; }
#define ATT_VALID(c) ((c) >= 3 || (!isctx && ((c) == 1 || ((c) == 0 && nb > 0) || ((c) == 2 && nb < 15))))
#define ATT_KROW(c) ((c) >= 3 ? TL + b * LCTX + ((c) - 3) * 128 : b * SEQ + (nb - 1 + (c)) * 128)
    int ch = 0; while (!ATT_VALID(ch)) ++ch;
    u32x4 kreg[2], vreg[2];
    { const int krow0 = ATT_KROW(ch);
#pragma unroll
      for (int i = 0; i < 2; ++i) { const int p = tid + 512 * i; const int key = p >> 3, seg = p & 7;
          kreg[i] = *(const u32x4*)(KB + (size_t)(krow0 + key) * 128 + g * 64 + seg * 8); vreg[i] = *(const u32x4*)(VB + (size_t)(krow0 + key) * 128 + g * 64 + seg * 8); } }
    while (ch < 5) {
        const int mask = ch == 0 ? 1 : (ch == 2 ? 2 : 0);
        int nch = ch + 1; while (nch < 5 && !ATT_VALID(nch)) ++nch;
        __syncthreads();
#pragma unroll
        for (int i = 0; i < 2; ++i) { const int p = tid + 512 * i; const int key = p >> 3, seg = p & 7;
            *(LAS u32x4*)(KL + key * KS + seg * 8) = kreg[i];
            const u32x4 vv = vreg[i]; const int kc = key ^ (seg << 2);
            VT[(seg * 8 + 0) * VS + kc] = (bf16_t)(vv.x & 0xffffu); VT[(seg * 8 + 1) * VS + kc] = (bf16_t)(vv.x >> 16);
            VT[(seg * 8 + 2) * VS + kc] = (bf16_t)(vv.y & 0xffffu); VT[(seg * 8 + 3) * VS + kc] = (bf16_t)(vv.y >> 16);
            VT[(seg * 8 + 4) * VS + kc] = (bf16_t)(vv.z & 0xffffu); VT[(seg * 8 + 5) * VS + kc] = (bf16_t)(vv.z >> 16);
            VT[(seg * 8 + 6) * VS + kc] = (bf16_t)(vv.w & 0xffffu); VT[(seg * 8 + 7) * VS + kc] = (bf16_t)(vv.w >> 16); }
        __syncthreads();
        if (nch < 5) { const int krow0 = ATT_KROW(nch);
#pragma unroll
            for (int i = 0; i < 2; ++i) { const int p = tid + 512 * i; const int key = p >> 3, seg = p & 7;
                kreg[i] = *(const u32x4*)(KB + (size_t)(krow0 + key) * 128 + g * 64 + seg * 8); vreg[i] = *(const u32x4*)(VB + (size_t)(krow0 + key) * 128 + g * 64 + seg * 8); } }
#pragma unroll 1
        for (int kt = 0; kt < 4; ++kt) {
            f32x16 sc;
#pragma unroll
            for (int r = 0; r < 16; ++r) sc[r] = 0.f;
#pragma unroll
            for (int s = 0; s < 4; ++s) { const bf16x8 kf = *(const LAS bf16x8*)(KL + (kt * 32 + (lane & 31)) * KS + 16 * s + 8 * hh); sc = __builtin_amdgcn_mfma_f32_32x32x16_bf16(kf, qf[s], sc, 0, 0, 0); }
            if (mask) {
#pragma unroll
                for (int r = 0; r < 16; ++r) { const int kj = kt * 32 + (r & 3) + 8 * (r >> 2) + 4 * hh; const bool ok = mask == 1 ? (kj >= qi) : (kj <= qi); if (!ok) sc[r] = -INFINITY; }
            }
            float mx = sc[0];
#pragma unroll
            for (int r = 1; r < 16; ++r) mx = fmaxf(mx, sc[r]);
            mx = fmaxf(mx, __shfl_xor(mx, 32));
            const float mnew = fmaxf(mrun, mx); const float alpha = exp2f(mrun - mnew); mrun = mnew;
            float ps = 0.f; float p[16];
#pragma unroll
            for (int r = 0; r < 16; ++r) { p[r] = exp2f(sc[r] - mnew); ps += p[r]; }
            lrun = lrun * alpha + ps;
#pragma unroll
            for (int r = 0; r < 16; ++r) { o0[r] *= alpha; o1[r] *= alpha; }
#pragma unroll
            for (int s2 = 0; s2 < 2; ++s2) {
                bf16x8 pf; { u32x4 w; w.x = pk2(p[8 * s2 + 0], p[8 * s2 + 1]); w.y = pk2(p[8 * s2 + 2], p[8 * s2 + 3]); w.z = pk2(p[8 * s2 + 4], p[8 * s2 + 5]); w.w = pk2(p[8 * s2 + 6], p[8 * s2 + 7]); pf = __builtin_bit_cast(bf16x8, w); }
                const int kbase = kt * 32 + 16 * s2 + 4 * hh;
#pragma unroll
                for (int dh = 0; dh < 2; ++dh) {
                    const int dd = dh * 32 + (lane & 31); const int sw = ((dd >> 3) & 7) << 2;
                    const LAS bf16_t* vp = VT + dd * VS;
                    const u32x2 lo = *(const LAS u32x2*)(vp + (kbase ^ sw)), hi = *(const LAS u32x2*)(vp + ((kbase + 8) ^ sw));
                    u32x4 w; w.x = lo.x; w.y = lo.y; w.z = hi.x; w.w = hi.y; const bf16x8 vf = __builtin_bit_cast(bf16x8, w);
                    if (dh == 0) o0 = __builtin_amdgcn_mfma_f32_32x32x16_bf16(vf, pf, o0, 0, 0, 0); else o1 = __builtin_amdgcn_mfma_f32_32x32x16_bf16(vf, pf, o1, 0, 0, 0);
                }
            }
        }
        ch = nch;
    }
#undef ATT_VALID
#undef ATT_KROW
    const float ltot = lrun + __shfl_xor(lrun, 32); const float inv = 1.0f / ltot;
    bf16_t* orow = YA + (size_t)qrow * BW + head * 64;
#pragma unroll
    for (int g4 = 0; g4 < 4; ++g4) {
        const f32x4 v0 = (f32x4){o0[4 * g4], o0[4 * g4 + 1], o0[4 * g4 + 2], o0[4 * g4 + 3]} * inv, v1 = (f32x4){o1[4 * g4], o1[4 * g4 + 1], o1[4 * g4 + 2], o1[4 * g4 + 3]} * inv;
        *(u32x2*)(orow + 8 * g4 + 4 * hh) = f32_to_bf4(v0); *(u32x2*)(orow + 32 + 8 * g4 + 4 * hh) = f32_to_bf4(v1);
    }
    __syncthreads();
}

__device__ __forceinline__ void sgu_unit(const Args& a, int l, int u, LAS unsigned char* lds, int tid_in, int lane_in, int wave) {
    int tid = tid_in; asm volatile("" : "+v"(tid)); const int lane = tid & 63; (void)lane_in;
    unsigned char* ws = launder_g(a.ws);
    const bf16_t* GU = (const bf16_t*)(ws + WS_GU); const bf16_t* GV = (const bf16_t*)(ws + WS_GV); bf16_t* YB = (bf16_t*)(ws + WS_Y) + (size_t)TT * BW;
    constexpr int VS = 136;
    LAS bf16_t* VT = (LAS bf16_t*)lds;
    const int chunk = u >> 2, g = u & 3; const int r0 = chunk * 128;
    const float* lng = a.in[I_SLNG] + l * BW; const float* lnb = a.in[I_SLNB] + l * BW;
    __syncthreads();
    u32x4 raw16[16];
#pragma unroll
    for (int t = 0; t < 16; ++t) raw16[t] = *(const u32x4*)(GV + (size_t)(r0 + wave * 16 + t) * BW + lane * 8);
    float lgv[8], lbv[8];
#pragma unroll
    for (int i = 0; i < 8; ++i) { lgv[i] = lng[lane * 8 + i]; lbv[i] = lnb[lane * 8 + i]; }
    float mu16[16], var16[16];
#pragma unroll
    for (int t = 0; t < 16; ++t) { const u32x4 raw = raw16[t]; mu16[t] = ((bflo(raw.x) + bfhi(raw.x)) + (bflo(raw.y) + bfhi(raw.y))) + ((bflo(raw.z) + bfhi(raw.z)) + (bflo(raw.w) + bfhi(raw.w))); }
    wave_sum_n<16>(mu16);
#pragma unroll
    for (int t = 0; t < 16; ++t) { const u32x4 raw = raw16[t]; const float mu = mu16[t] * (1.0f / BW); mu16[t] = mu;
        const float d0 = bflo(raw.x) - mu, d1 = bfhi(raw.x) - mu, d2 = bflo(raw.y) - mu, d3 = bfhi(raw.y) - mu, d4 = bflo(raw.z) - mu, d5 = bfhi(raw.z) - mu, d6 = bflo(raw.w) - mu, d7 = bfhi(raw.w) - mu;
        var16[t] = ((d0 * d0 + d1 * d1) + (d2 * d2 + d3 * d3)) + ((d4 * d4 + d5 * d5) + (d6 * d6 + d7 * d7)); }
    wave_sum_n<16>(var16);
    if ((lane >> 4) == g) { const int cl = (lane & 15) * 8;
#pragma unroll
        for (int t = 0; t < 16; ++t) { const int q = wave * 16 + t; const u32x4 raw = raw16[t]; const float mu = mu16[t]; const float rstd = 1.0f / sqrtf(var16[t] * (1.0f / BW) + 1e-5f);
            const float v[8] = {bflo(raw.x), bfhi(raw.x), bflo(raw.y), bfhi(raw.y), bflo(raw.z), bfhi(raw.z), bflo(raw.w), bfhi(raw.w)};
#pragma unroll
            for (int i = 0; i < 8; ++i) { const float vn = (v[i] - mu) * rstd * lgv[i] + lbv[i]; VT[(cl + i) * VS + q] = (bf16_t)f2bf(vn); } }
    }
    __syncthreads();
    const float* Wsg = a.in[I_SGUW] + ((size_t)l * 4 + g) * 128 * 128;
    const int fr = lane & 15, fq = lane >> 4; const int pl = wave * 16 + fr;
    bf16x8 wf[4];
#pragma unroll
    for (int ks = 0; ks < 4; ++ks) { const f32x4 w0 = *(const f32x4*)(Wsg + (size_t)pl * 128 + 32 * ks + 8 * fq), w1 = *(const f32x4*)(Wsg + (size_t)pl * 128 + 32 * ks + 8 * fq + 4);
        u32x4 w; w.x = pk2(w0[0], w0[1]); w.y = pk2(w0[2], w0[3]); w.z = pk2(w1[0], w1[1]); w.w = pk2(w1[2], w1[3]); wf[ks] = __builtin_bit_cast(bf16x8, w); }
    const float bias = a.in[I_SGUB][((size_t)l * 4 + g) * 128 + pl];
    const int row = r0 + pl;
#pragma unroll
    for (int cg = 0; cg < 8; ++cg) {
        f32x4 acc = (f32x4){0.f, 0.f, 0.f, 0.f};
#pragma unroll
        for (int ks = 0; ks < 4; ++ks) { const bf16x8 vf = *(const LAS bf16x8*)(VT + (cg * 16 + fr) * VS + 32 * ks + 8 * fq); acc = __builtin_amdgcn_mfma_f32_16x16x32_bf16(vf, wf[ks], acc, 0, 0, 0); }
        const int c = g * 128 + cg * 16 + 4 * fq;
        const f32x4 gu = bf4_to_f32(*(const u32x2*)(GU + (size_t)row * BW + c));
        *(u32x2*)(YB + (size_t)row * BW + c) = f32_to_bf4(gu * (acc + bias));
    }
}

template <int J> __device__ __forceinline__ void conv_acc(float (&o)[32], const float (&w)[31], float z) {
#pragma unroll
    for (int k = 0; k < 31; ++k) { const int i = J - k; if (i >= 0 && i < 32) o[i] += w[k] * z; }
}
template <int J> __device__ __forceinline__ void conv_rows(float (&o)[32], const float (&w)[31], const LAS bf16_t* zp) {
    if constexpr (J < 62) { conv_acc<J>(o, w, __builtin_bit_cast(float, (unsigned)zp[J * 512] << 16)); conv_rows<J + 1>(o, w, zp); }
}
__device__ __forceinline__ bool seq_start(int row) { return row < TL ? ((row & 2047) == 0) : (((row - TL) & 255) == 0); }
__device__ __forceinline__ void conf_unit(const Args& a, int l, int u, LAS unsigned char* lds, int tid_in, int lane_in, int wave) {
    int tid = tid_in; asm volatile("" : "+v"(tid)); const int lane = tid & 63; (void)lane_in;
    unsigned char* ws = launder_g(a.ws);
    const bf16_t* Z = (const bf16_t*)(ws + WS_Z); bf16_t* YD = (bf16_t*)(ws + WS_Y) + (size_t)3 * TT * BW;
    LAS bf16_t* ZL = (LAS bf16_t*)lds;
    LAS float* RED = (LAS float*)(lds + 63488);
    LAS float* STAT = RED + 512;
    const int r0 = u * 32;
    const int ss = r0 < TL ? (r0 & ~2047) : TL + ((r0 - TL) & ~255); const int se = ss + (r0 < TL ? SEQ : LCTX);
    __syncthreads();
    {
        u32x4 zv[8];
#pragma unroll
        for (int i = 0; i < 8; ++i) { const int p = tid + NTHR * i; const int j = p >> 6, seg = p & 63; const int row = r0 - 15 + j;
            zv[i] = (u32x4){0u, 0u, 0u, 0u}; if (j < 62 && row >= ss && row < se) zv[i] = *(const u32x4*)(Z + (size_t)row * BW + seg * 8); }
#pragma unroll
        for (int i = 0; i < 8; ++i) { const int p = tid + NTHR * i; const int j = p >> 6, seg = p & 63; if (j < 62) *(LAS u32x4*)(ZL + j * 512 + seg * 8) = zv[i]; }
    }
    __syncthreads();
    const int c = tid;
    float w[31];
    const float* wbase = a.in[I_CDW] + (size_t)l * 31 * BW; int wo = c;
#pragma unroll
    for (int k = 0; k < 31; ++k) { asm volatile("" : "+v"(wo)); w[k] = wbase[wo]; wo += BW; }
    const float bias = a.in[I_CDB][l * BW + c];
    float o[32];
#pragma unroll
    for (int i = 0; i < 32; ++i) o[i] = bias;
    conv_rows<0>(o, w, ZL + c);
    { float sv[32], qv[32];
#pragma unroll
      for (int i = 0; i < 32; ++i) { sv[i] = o[i]; qv[i] = o[i] * o[i]; }
      wave_sum_n<32>(sv); wave_sum_n<32>(qv);
      if (lane == 0) {
#pragma unroll
          for (int i = 0; i < 32; ++i) { RED[wave * 64 + i] = sv[i]; RED[wave * 64 + 32 + i] = qv[i]; } } }
    __syncthreads();
    if (tid < 32) { float s = 0.f, q = 0.f;
#pragma unroll
        for (int wv = 0; wv < 8; ++wv) { s += RED[wv * 64 + tid]; q += RED[wv * 64 + 32 + tid]; }
        const float mu = s * (1.0f / BW); const float var = fmaxf(q * (1.0f / BW) - mu * mu, 0.f); STAT[tid] = mu; STAT[32 + tid] = 1.0f / sqrtf(var + 1e-5f); }
    __syncthreads();
    const float lg = a.in[I_CLNG][l * BW + c], lb = a.in[I_CLNB][l * BW + c];
    int yo = r0 * BW + c;
#pragma unroll
    for (int i = 0; i < 32; ++i) { asm volatile("" : "+v"(yo)); const float y = (o[i] - STAT[i]) * STAT[32 + i] * lg + lb; YD[yo] = (bf16_t)f2bf(siluf_(y)); yo += BW; }
}

__device__ __forceinline__ void sconv_unit(const Args& a, int l, int u, int tid) {
    unsigned char* ws = launder_g(a.ws);
    const bf16_t* CB = (const bf16_t*)(ws + WS_CB); const bf16_t* CU = (const bf16_t*)(ws + WS_CU); bf16_t* YC = (bf16_t*)(ws + WS_Y) + (size_t)2 * TT * BW;
    const float* W = a.in[I_SCW] + (size_t)l * 3 * BW;
#pragma unroll
    for (int i = 0; i < 4; ++i) { const int p = tid + 512 * i; const int row = u * 32 + (p >> 6), c0 = (p & 63) * 8;
        const bool hasp = !seq_start(row), hasn = (row + 1 < TT) && !seq_start(row + 1);
        const u32x4 z4 = (u32x4){0u, 0u, 0u, 0u};
        const u32x4 um = hasp ? *(const u32x4*)(CU + (size_t)(row - 1) * BW + c0) : z4, u0 = *(const u32x4*)(CU + (size_t)row * BW + c0), up = hasn ? *(const u32x4*)(CU + (size_t)(row + 1) * BW + c0) : z4;
        const u32x4 cb = *(const u32x4*)(CB + (size_t)row * BW + c0);
        const f32x4 wa0 = *(const f32x4*)(W + c0), wa1 = *(const f32x4*)(W + c0 + 4), wb0 = *(const f32x4*)(W + BW + c0), wb1 = *(const f32x4*)(W + BW + c0 + 4), wc0 = *(const f32x4*)(W + 2 * BW + c0), wc1 = *(const f32x4*)(W + 2 * BW + c0 + 4);
        const f32x4 y0 = bf4_to_f32((u32x2){cb.x, cb.y}) * (wa0 * bf4_to_f32((u32x2){um.x, um.y}) + wb0 * bf4_to_f32((u32x2){u0.x, u0.y}) + wc0 * bf4_to_f32((u32x2){up.x, up.y}));
        const f32x4 y1 = bf4_to_f32((u32x2){cb.z, cb.w}) * (wa1 * bf4_to_f32((u32x2){um.z, um.w}) + wb1 * bf4_to_f32((u32x2){u0.z, u0.w}) + wc1 * bf4_to_f32((u32x2){up.z, up.w}));
        const u32x2 a0 = f32_to_bf4(y0), a1 = f32_to_bf4(y1);
        *(u32x4*)(YC + (size_t)row * BW + c0) = (u32x4){a0.x, a0.y, a1.x, a1.y}; }
}

constexpr int N_PHASES = 18;
__global__ void __launch_bounds__(NTHR, 2) fwd_kernel(Args args) {
    extern __shared__ __attribute__((aligned(16))) unsigned char lds_raw[];
    LAS unsigned char* lds = (LAS unsigned char*)lds_raw;
    const int tid0 = threadIdx.x; const int wave_s = __builtin_amdgcn_readfirstlane(tid0 >> 6);
    const int G = gridDim.x, wg = blockIdx.x;
    unsigned char* ws = args.ws;
    unsigned* ctl = (unsigned*)(ws + WS_CTL);
    volatile LAS unsigned* MISC = (volatile LAS unsigned*)(lds + MISC_OFF);
    for (int u = tid0; u < (LDS_BYTES - LDSCTL_OFF) / 4; u += NTHR) ((LAS unsigned*)(lds + LDSCTL_OFF))[u] = 0u;
    __syncthreads();
    const int lo = args.ph_lo, hi = args.ph_hi;
    XcdBarrier bar; bar.bar = ctl + CW_BAR; bar.x = 0; bar.st = nullptr;
    if (hi - lo > 1) bar = xcd_barrier_post(ctl + CW_BAR, MISC + 8, tid0 == 0);
#ifndef PHASE_MASK
#define PHASE_MASK 0x3ff
#endif
#define PM(b) ((PHASE_MASK >> (b)) & 1)
#define IN(k) (lo <= (k) && (k) < hi)
#define FRESH_TID() int tid = wave_s * 64 + lane_id(); asm volatile("" : "+v"(tid)); const int lane = tid & 63, wave = wave_s;
#define REPEAT(b) _Pragma("unroll 1") for (int rep_ = 0; rep_ <= ((REP >> (b)) & 1); ++rep_)
#define WSL() launder_g(args.ws)
#define SEAM(k) do { if (IN(k) && IN((k) + 1)) { xcd_barrier(bar, wave_s == 0 && lane_id() == 0); if ((REP >> 9) & 1) { xcd_barrier(bar, wave_s == 0 && lane_id() == 0); xcd_barrier(bar, wave_s == 0 && lane_id() == 0); } } } while (0)

    if (PM(0) && IN(0)) REPEAT(0) { FRESH_TID(); p0_prologue(args, lds, tid, lane, wave, wg, G); }
    SEAM(0);
    for (int l = 0; l < 2; ++l) {
        const int P = 8 * l;
        const int nM = l == 0 ? 36 : 32;
        if (PM(1) && IN(P + 1)) for (int rep_ = 0; rep_ <= (((REP >> 1) & 1) && l == 0 ? 3 : 0); ++rep_) { FRESH_TID(); if (l == 0) norm_phase<0>(args, lane, wave, wg, G); else norm_phase<1>(args, lane, wave, wg, G); }
        SEAM(P + 1);
        if (PM(2) && IN(P + 2)) REPEAT(2) {
            unsigned char* ws = WSL(); unsigned* ctl = (unsigned*)(ws + WS_CTL); (void)ctl;
            SchedWin S{(const bf16_t*)(ws + WS_H), (const bf16_t*)(ws + WS_WIN) + (size_t)l * NIN * D, nM, l == 0 ? 0 : 4, G, wg};
            EpiWin E{ws, (const float*)(ws + WS_ROPE)};
            pg8::gemm_phase<EpiWin, SchedWin, false>(lds, D, S, E, wave_s);
        }
        SEAM(P + 2);
        if (PM(3) && IN(P + 3)) REPEAT(3) {
            const int nA = l == 0 ? 288 : 256, nS = nM * 8, nC = nM * 8;
            if (DBG_MIX & 1) { FRESH_TID(); for (int u = wg; u < nA; u += G) attn_unit(args, l, u, lds, tid, lane, wave); }
            if (DBG_MIX & 2) { FRESH_TID(); for (int u = (wg + G - 32) % G; u < nS; u += G) sgu_unit(args, l, u, lds, tid, lane, wave); }
            if (DBG_MIX & 4) { FRESH_TID(); for (int u = (wg + G - 64) % G; u < nC; u += G) conf_unit(args, l, u, lds, tid, lane, wave); }
            if (DBG_MIX & 8) { FRESH_TID(); for (int u = (wg + G - 96) % G; u < nC; u += G) sconv_unit(args, l, u, tid); }
        }
        SEAM(P + 3);
        if (PM(4) && IN(P + 4)) REPEAT(4) {
            unsigned char* ws = WSL(); unsigned* ctl = (unsigned*)(ws + WS_CTL); (void)ctl;
            SchedBranch S{(const bf16_t*)(ws + WS_Y), (const bf16_t*)(ws + WS_WB) + (size_t)l * 4 * D * BW, nM, G, wg};
            EpiBranch E{(const bf16_t*)(ws + WS_G), (float*)(ws + WS_MS) + (size_t)wg * 65536, (bf16_t*)(ws + WS_MG)};
            pg8::gemm_phase<EpiBranch, SchedBranch, false>(lds, BW, S, E, wave_s);
        }
        SEAM(P + 4);
        if (PM(5) && IN(P + 5)) for (int rep_ = 0; rep_ <= (((REP >> 5) & 1) && l == 0 ? 1 : 0); ++rep_) {
            unsigned char* ws = WSL(); unsigned* ctl = (unsigned*)(ws + WS_CTL); (void)ctl;
            SchedOut S{(const bf16_t*)(ws + WS_MG), (const bf16_t*)(ws + WS_WO) + (size_t)l * D * D, nM, G, wg};
            EpiOut E{l == 0 ? args.in[I_X] : (const float*)(ws + WS_XS), l == 0 ? args.in[I_CTX] : (const float*)(ws + WS_XS) + (size_t)TL * D, (float*)(ws + WS_XS), (const float*)(ws + WS_MOD) + (size_t)l * 5 * 12288 + 4096};
            pg8::gemm_phase<EpiOut, SchedOut, false>(lds, D, S, E, wave_s);
        }
        SEAM(P + 5);
        if (PM(6) && IN(P + 6)) { if ((REP >> 6) & 1) { FRESH_TID(); router_phase(args, l, lds, tid, lane, wave, wg, G, 1); } FRESH_TID(); router_phase(args, l, lds, tid, lane, wave, wg, G, 0); }
        SEAM(P + 6);
        if (PM(7) && IN(P + 7)) REPEAT(7) {
            unsigned char* ws = WSL(); unsigned* ctl = (unsigned*)(ws + WS_CTL); (void)ctl;
            { FRESH_TID(); moe_build_list(lds, ctl + CW_CNT + 1024 * l, G, wg, tid); }
            SchedMoe<true> S{lds, (const bf16_t*)(ws + WS_H), (const bf16_t*)(ws + WS_WUP) + (size_t)l * NE * D * D, (const int*)(ws + WS_LT)};
            EpiUp E{(bf16_t*)(ws + WS_ACT)};
            pg8::gemm_phase<EpiUp, SchedMoe<true>, true>(lds, D, S, E, wave_s);
        }
        SEAM(P + 7);
        if (PM(8) && IN(P + 8)) REPEAT(8) {
            unsigned char* ws = WSL(); unsigned* ctl = (unsigned*)(ws + WS_CTL); (void)ctl;
            { FRESH_TID(); moe_build_list(lds, ctl + CW_CNT + 1024 * l, G, wg, tid); }
            SchedMoe<false> S{lds, (const bf16_t*)(ws + WS_ACT), (const bf16_t*)(ws + WS_WDN) + (size_t)l * NE * D * DFF, (const int*)(ws + WS_LT)};
            EpiDown E{(const int*)(ws + WS_LT), (const float*)(ws + WS_LW), (bf16_t*)(ws + WS_YT)};
            pg8::gemm_phase<EpiDown, SchedMoe<false>, false>(lds, DFF, S, E, wave_s);
        }
        SEAM(P + 8);
    }
    if (PM(9) && IN(17)) { FRESH_TID(); norm_phase<2>(args, lane, wave, wg, G); }
#undef IN
#undef SEAM
}

extern "C" void kernel_launch(void* const* d_in, const int* in_sizes, int n_in, void* d_out, int out_size, void* d_ws, size_t ws_size, hipStream_t stream) {
    static int grid = 0;
    if (grid == 0) {
        if (n_in != 26 || out_size != TL * D || ws_size < WS_END) { fprintf(stderr, "kernel_launch: unexpected shapes (n_in %d, out %d, ws %zu < %zu)\n", n_in, out_size, ws_size, (size_t)WS_END); grid = -1; return; }
        int dev = 0, cus = 0, per_cu = 0;
        if (hipGetDevice(&dev) != hipSuccess || hipDeviceGetAttribute(&cus, hipDeviceAttributeMultiprocessorCount, dev) != hipSuccess) { grid = -1; return; }
        if (hipFuncSetAttribute((const void*)fwd_kernel, hipFuncAttributeMaxDynamicSharedMemorySize, LDS_BYTES) != hipSuccess) { fprintf(stderr, "kernel_launch: hipFuncSetAttribute failed\n"); grid = -1; return; }
        if (hipOccupancyMaxActiveBlocksPerMultiprocessor(&per_cu, (const void*)fwd_kernel, NTHR, LDS_BYTES) != hipSuccess || per_cu < 1) fprintf(stderr, "kernel_launch: occupancy query reports %d\n", per_cu);
        (void)hipGetLastError();
        grid = cus < 256 ? cus : 256;
    }
    if (grid < 0) return;
    (void)hipMemsetAsync((char*)d_ws + WS_CTL, 0, CTL_BYTES, stream);
    Args a{};
    for (int i = 0; i < 26; ++i) a.in[i] = (const float*)d_in[i];
    a.out = (float*)d_out; a.ws = (unsigned char*)d_ws;
#if MK_N_LAUNCHES == 1
    a.ph_lo = 0; a.ph_hi = N_PHASES;
    hipLaunchKernelGGL(fwd_kernel, dim3(grid), dim3(NTHR), LDS_BYTES, stream, a);
#else
#ifndef DBG_LAST
#define DBG_LAST N_PHASES
#endif
    for (int p = 0; p < DBG_LAST; ++p) { a.ph_lo = p; a.ph_hi = p + 1; hipLaunchKernelGGL(fwd_kernel, dim3(grid), dim3(NTHR), LDS_BYTES, stream, a); }
#endif
}
```
